# Optimizing an MI355X kernel written in HIP

```python
import math
import jax, jax.numpy as jnp
from jax import lax
import numpy as np

D_MODEL = 2048
BATCH = 8
SEQ = 4096
DEPTH = 4
DEC_BATCH = 2
DEC_SEQ = 4096
PAST_LEN = 128

GRID_W = 64
WIN_H = 8
WIN_W = 16
DH = 128
H_A = D_MODEL // 256
D_A = H_A * DH
D_B = D_MODEL // 2
EMB = 33
FO = 64
FAST_DECAY = 0.3
SLOW_DECAY = 1.5
DECAY_TARGET = 1e-2
D_C = D_MODEL
G_C = 8
DG_C = D_C // G_C
CHUNK = 128
D_FF = 4 * D_MODEL
N_EVEN = (DEPTH + 1) // 2
N_ODD = DEPTH // 2
D_IN_AB = 3 * D_A + 3 * D_B
D_MIX_AB = D_A + D_B
EPS = 1e-6

kernel_name = "hybrid_natten_hyena_gmlp_encoder"


def rmsnorm(x, g):
    xf = x.astype(jnp.float32)
    y = xf * lax.rsqrt(jnp.mean(xf * xf, axis=-1, keepdims=True) + EPS) * g.astype(jnp.float32)
    return y.astype(x.dtype)


def neighbourhood_attention(q, k, v, q_gain, k_gain, rpb):
    B, L, H, Dh = q.shape
    rows = L // GRID_W
    kh = min(WIN_H, rows)
    q = (rmsnorm(q, q_gain) * (Dh ** -0.5)).reshape(B, rows, GRID_W, H, Dh)
    k = rmsnorm(k, k_gain).reshape(B, rows, GRID_W, H, Dh)
    v = v.reshape(B, rows, GRID_W, H, Dh)
    col = jnp.arange(GRID_W)
    cs = jnp.clip(col - WIN_W // 2, 0, GRID_W - WIN_W)
    qc, kc = col[:, None], col[None, :]
    col_ok = (kc >= cs[:, None]) & (kc < cs[:, None] + WIN_W)
    dc = jnp.clip(kc - qc, -(WIN_W - 1), WIN_W - 1) + WIN_W - 1
    bias_c = rpb.astype(jnp.float32)[:, :, dc]
    bias_c = jnp.where(col_ok, bias_c, -jnp.inf)

    def row_block(r):
        rs = jnp.clip(r - kh // 2, 0, rows - kh)
        q_r = lax.dynamic_index_in_dim(q, r, axis=1, keepdims=False)
        k_r = lax.dynamic_slice_in_dim(k, rs, kh, axis=1)
        v_r = lax.dynamic_slice_in_dim(v, rs, kh, axis=1)
        dr = rs + jnp.arange(kh) - r + WIN_H - 1
        bias = jnp.take(bias_c, dr, axis=1).transpose(0, 2, 1, 3)
        s = jnp.einsum('bqhd,bikhd->bhqik', q_r, k_r).astype(jnp.float32) + bias
        p = jax.nn.softmax(s.reshape(B, H, GRID_W, kh * GRID_W), axis=-1)
        p = p.reshape(B, H, GRID_W, kh, GRID_W).astype(v.dtype)
        return jnp.einsum('bhqik,bikhd->bqhd', p, v_r)

    o = lax.map(row_block, jnp.arange(rows))
    return o.transpose(1, 0, 2, 3, 4).reshape(B, L, H * Dh)


def short_conv3(z, w, b):
    zp = jnp.pad(z, ((0, 0), (1, 1), (0, 0)))
    return zp[:, :-2] * w[0] + zp[:, 1:-1] * w[1] + zp[:, 2:] * w[2] + b


def hyena_kernel(L, f_w1, f_b1, f_w2, f_b2, f_w3, f_b3, f_wout, f_freq):
    f32 = jnp.float32
    t = jnp.linspace(0.0, 1.0, L, dtype=f32)[:, None]
    bands = (EMB - 1) // 2
    w = 2.0 * math.pi * jnp.arange(L, dtype=f32)[:, None] / L
    f = jnp.linspace(1e-4, bands - 1, bands, dtype=f32)[None, :]
    z = jnp.concatenate([t, jnp.cos(f * w), -jnp.sin(f * w)], axis=-1)
    fr = f_freq.astype(f32)
    h = jnp.sin(fr * (z @ f_w1.astype(f32) + f_b1.astype(f32)))
    h = jnp.sin(fr * (h @ f_w2.astype(f32) + f_b2.astype(f32)))
    h = jnp.sin(fr * (h @ f_w3.astype(f32) + f_b3.astype(f32)))
    h = h @ f_wout.astype(f32)
    deltas = jnp.abs(jnp.linspace(math.log(DECAY_TARGET) / FAST_DECAY,
                                  math.log(DECAY_TARGET) / SLOW_DECAY, D_B, dtype=f32))
    decay = jnp.exp(-t * deltas)
    h_fwd = h[:, :D_B] * decay
    h_bwd = h[:, D_B:] * decay
    kern = jnp.concatenate([h_fwd, jnp.zeros((1, D_B), f32), h_bwd[:0:-1]], axis=0)
    return kern / jnp.sum(jnp.abs(kern), axis=0, keepdims=True)


def hyena(z, kern, h_bias):
    B, L, _ = z.shape
    x0, x1, v = jnp.split(z, 3, axis=-1)
    u = (v * x1).astype(jnp.float32)
    y = jnp.fft.irfft(jnp.fft.rfft(u, n=2 * L, axis=1) * jnp.fft.rfft(kern, axis=0)[None],
                      n=2 * L, axis=1)[:, :L]
    y = y + u * h_bias.astype(jnp.float32)
    return (y * x0.astype(jnp.float32)).astype(z.dtype)


def mixer_ab(h, w_in, sc_w, sc_b, q_gain, k_gain, rpb, f_w1, f_b1, f_w2, f_b2, f_w3, f_b3,
             f_wout, f_freq, h_bias, w_out):
    B, L, _ = h.shape
    p = h @ w_in
    q = p[..., :D_A].reshape(B, L, H_A, DH)
    k = p[..., D_A:2 * D_A].reshape(B, L, H_A, DH)
    v = p[..., 2 * D_A:3 * D_A].reshape(B, L, H_A, DH)
    a = neighbourhood_attention(q, k, v, q_gain, k_gain, rpb)
    z = short_conv3(p[..., 3 * D_A:], sc_w, sc_b)
    kern = hyena_kernel(L, f_w1, f_b1, f_w2, f_b2, f_w3, f_b3, f_wout, f_freq)
    b = hyena(z, kern, h_bias)
    return jnp.concatenate([a, b], axis=-1) @ w_out


def mixer_c(h, w_in, v_gain, w_s, b_s, w_out):
    B, L, _ = h.shape
    zz = jax.nn.gelu(h @ w_in)
    u, v = jnp.split(zz, 2, axis=-1)
    v = rmsnorm(v, v_gain).reshape(B, L // CHUNK, CHUNK, G_C, DG_C)
    s = jnp.einsum('gpq,bnqgc->bnpgc', w_s, v) + b_s.T[None, None, :, :, None]
    return (u * s.reshape(B, L, D_C)) @ w_out


def mlp_sqrelu(h, w1, w2):
    return jnp.square(jax.nn.relu(h @ w1)) @ w2


def trunk(x, norm_mix, norm_mlp, w_in_ab, sc_w, sc_b, q_gain, k_gain, rpb, f_w1, f_b1, f_w2, f_b2,
          f_w3, f_b3, f_wout, f_freq, h_bias, w_out_ab, w_in_c, v_gain, w_s, b_s, w_out_c,
          w_mlp1, w_mlp2):
    for i in range(DEPTH):
        j = i // 2
        h = rmsnorm(x, norm_mix[i])
        if i % 2 == 0:
            x = x + mixer_ab(h, w_in_ab[j], sc_w[j], sc_b[j], q_gain[j], k_gain[j], rpb[j],
                             f_w1[j], f_b1[j], f_w2[j], f_b2[j], f_w3[j], f_b3[j], f_wout[j],
                             f_freq[j], h_bias[j], w_out_ab[j])
        else:
            x = x + mixer_c(h, w_in_c[j], v_gain[j], w_s[j], b_s[j], w_out_c[j])
        x = x + mlp_sqrelu(rmsnorm(x, norm_mlp[i]), w_mlp1[i], w_mlp2[i])
    return x


def setup_inputs(seed: int = 0) -> dict:
    key = jax.random.key(seed)
    ks = iter(jax.random.split(key, 40))

    def nrm(shape, scale):
        return jax.random.normal(next(ks), shape, jnp.float32) * scale

    def gain(shape):
        return 1.0 + nrm(shape, 0.05)

    return {
        "x_prompt": nrm((BATCH, SEQ, D_MODEL), 1.0),
        "x_sample": nrm((DEC_BATCH, DEC_SEQ, D_MODEL), 1.0),
        "norm_mix": gain((DEPTH, D_MODEL)),
        "norm_mlp": gain((DEPTH, D_MODEL)),
        "w_in_ab": nrm((N_EVEN, D_MODEL, D_IN_AB), D_MODEL ** -0.5),
        "sc_w": nrm((N_EVEN, 3, 3 * D_B), 3 ** -0.5),
        "sc_b": nrm((N_EVEN, 3 * D_B), 0.02),
        "q_gain": gain((N_EVEN, DH)),
        "k_gain": gain((N_EVEN, DH)),
        "rpb": nrm((N_EVEN, H_A, 2 * WIN_H - 1, 2 * WIN_W - 1), 0.1),
        "f_w1": nrm((N_EVEN, EMB, FO), EMB ** -0.5),
        "f_b1": nrm((N_EVEN, FO), 0.1),
        "f_w2": nrm((N_EVEN, FO, FO), FO ** -0.5),
        "f_b2": nrm((N_EVEN, FO), 0.1),
        "f_w3": nrm((N_EVEN, FO, FO), FO ** -0.5),
        "f_b3": nrm((N_EVEN, FO), 0.1),
        "f_wout": nrm((N_EVEN, FO, 2 * D_B), FO ** -0.5),
        "f_freq": 1.0 + nrm((N_EVEN, FO), 0.1),
        "h_bias": nrm((N_EVEN, D_B), 0.5),
        "w_out_ab": nrm((N_EVEN, D_MIX_AB, D_MODEL), D_MIX_AB ** -0.5),
        "w_in_c": nrm((N_ODD, D_MODEL, 2 * D_C), D_MODEL ** -0.5),
        "v_gain": gain((N_ODD, D_C)),
        "w_s": nrm((N_ODD, G_C, CHUNK, CHUNK), CHUNK ** -0.5),
        "b_s": 1.0 + nrm((N_ODD, G_C, CHUNK), 0.1),
        "w_out_c": nrm((N_ODD, D_C, D_MODEL), D_C ** -0.5),
        "w_mlp1": nrm((DEPTH, D_MODEL, D_FF), D_MODEL ** -0.5),
        "w_mlp2": nrm((DEPTH, D_FF, D_MODEL), D_FF ** -0.5),
    }


def reference(x_prompt, x_sample, norm_mix, norm_mlp, w_in_ab, sc_w, sc_b, q_gain, k_gain, rpb,
              f_w1, f_b1, f_w2, f_b2, f_w3, f_b3, f_wout, f_freq, h_bias, w_out_ab, w_in_c,
              v_gain, w_s, b_s, w_out_c, w_mlp1, w_mlp2):
    y_prompt = trunk(x_prompt, norm_mix, norm_mlp, w_in_ab, sc_w, sc_b, q_gain, k_gain, rpb,
                     f_w1, f_b1, f_w2, f_b2, f_w3, f_b3, f_wout, f_freq, h_bias, w_out_ab,
                     w_in_c, v_gain, w_s, b_s, w_out_c, w_mlp1, w_mlp2)
    y_sample = trunk(x_sample, norm_mix, norm_mlp, w_in_ab, sc_w, sc_b, q_gain, k_gain, rpb,
                     f_w1, f_b1, f_w2, f_b2, f_w3, f_b3, f_wout, f_freq, h_bias, w_out_ab,
                     w_in_c, v_gain, w_s, b_s, w_out_c, w_mlp1, w_mlp2)
    return (y_prompt, y_sample)
```

```cpp
#include <hip/hip_runtime.h>
#include <cstdio>
#include <cstdint>
#include <cmath>
namespace pg8 {
#define PG8_LAS __attribute__((address_space(3)))
typedef unsigned short bf16_t;
typedef short bf16x8 __attribute__((ext_vector_type(8)));
typedef float f32x4 __attribute__((ext_vector_type(4)));
typedef unsigned u32x4 __attribute__((ext_vector_type(4)));
constexpr int BM = 256, BK = 64, HALF = 128, HTB = HALF * BK * 2  , STAGE_BYTES = 8 * HTB, NXCD = 8, WGM = 8;

__host__ __device__ __forceinline__ int lds_byte(int r, int c) { const int st = (r >> 4) * 2 + (c >> 5), rr = r & 15, cc = c & 31, ob = rr * 64 + cc * 2; return st * 1024 + (ob ^ (((ob >> 9) & 1) << 5)); }
__host__ __device__ __forceinline__ void stage_rc(int b, int& R, int& C) { const int st = b / 1024, sb = b % 1024, swz = sb ^ (((sb >> 9) & 1) << 5); R = (st >> 1) * 16 + swz / 64; C = (st & 1) * 32 + (swz % 64) / 2; }
__host__ __device__ __forceinline__ int perm32(int rho) { const int n = rho >> 4, i = rho & 15; return 8 * (i >> 2) + 4 * n + (i & 3); }

struct Unit { int pm, pn; };
struct Gemm { const bf16_t* A; const bf16_t* Bt; int M, N, K, lda, wbase; };
__device__ __forceinline__ int lane_id_asm() { int l; asm volatile("v_mbcnt_lo_u32_b32 %0, -1, 0\n\tv_mbcnt_hi_u32_b32 %0, -1, %0" : "=v"(l)); return l; }

struct StaticOrder {
    int nM, nN, nwg, G, c;
    __host__ __device__ void init(int M, int N, int G_, int c_) { nM = M / BM; nN = N / BM; nwg = nM * nN; G = G_; c = c_; }
    __host__ __device__ bool next(int i, Unit& u) const {
        const long L = (long)i * G + c; if (L >= nwg) return false;
        int wgid = (int)L; { const int q = nwg / NXCD, r = nwg % NXCD, xcd = wgid % NXCD, off = wgid / NXCD; wgid = (xcd < r ? xcd * (q + 1) : r * (q + 1) + (xcd - r) * q) + off; }
        const int nig = WGM * nN, gid = wgid / nig, fm = gid * WGM, gsz = (nM - fm) < WGM ? (nM - fm) : WGM;
        u.pm = fm + ((wgid % nig) % gsz); u.pn = (wgid % nig) / gsz; return true;
    }
    __device__ __forceinline__ void a_ready(const Unit&) const {}
    __device__ __forceinline__ void done(const Unit&) const {}
};

#define PG8_GAS __attribute__((address_space(1)))
__device__ __forceinline__ unsigned cvt_pk_bf16(float lo, float hi) { unsigned r; asm volatile("v_cvt_pk_bf16_f32 %0, %1, %2" : "=v"(r) : "v"(lo), "v"(hi)); return r; }
__device__ __forceinline__ f32x4 zero4() { f32x4 z; asm volatile("v_mov_b32 %0, 0\n\tv_mov_b32 %1, 0\n\tv_mov_b32 %2, 0\n\tv_mov_b32 %3, 0" : "=v"(z[0]), "=v"(z[1]), "=v"(z[2]), "=v"(z[3])); return z; }
__device__ __forceinline__ float sum_rows4(float v) {
    unsigned u = __builtin_bit_cast(unsigned, v);
    const auto r = __builtin_amdgcn_permlane16_swap(u, u, false, false);
    const float s = __builtin_bit_cast(float, (unsigned)r[0]) + __builtin_bit_cast(float, (unsigned)r[1]);
    u = __builtin_bit_cast(unsigned, s);
    const auto q = __builtin_amdgcn_permlane32_swap(u, u, false, false);
    return __builtin_bit_cast(float, (unsigned)q[0]) + __builtin_bit_cast(float, (unsigned)q[1]);
}
__device__ __forceinline__ float max_rows4(float v) {
    unsigned u = __builtin_bit_cast(unsigned, v);
    const auto r = __builtin_amdgcn_permlane16_swap(u, u, false, false);
    const float s = fmaxf(__builtin_bit_cast(float, (unsigned)r[0]), __builtin_bit_cast(float, (unsigned)r[1]));
    u = __builtin_bit_cast(unsigned, s);
    const auto q = __builtin_amdgcn_permlane32_swap(u, u, false, false);
    return fmaxf(__builtin_bit_cast(float, (unsigned)q[0]), __builtin_bit_cast(float, (unsigned)q[1]));
}
__device__ __forceinline__ void add_f32_ret(float* p, float v) { const float old = __hip_atomic_fetch_add(p, v, __ATOMIC_RELAXED, __HIP_MEMORY_SCOPE_AGENT); asm volatile("" :: "v"(old)); }
__device__ __forceinline__ float gelu_tanh(float x) {
    const float a2 = 1.5957691216f * x * (1.0f + 0.044715f * x * x);
    const float e = __builtin_amdgcn_exp2f(-1.4426950408889634f * a2);
    return x * __builtin_amdgcn_rcpf(1.0f + e);
}
template <int ACT> __device__ __forceinline__ float act_fn(float v) {
    if (ACT == 1) return gelu_tanh(v);
    if (ACT == 2) { const float r = v > 0.f ? v : 0.f; return r * r; }
    return v;
}
template <int ACT, bool RVS, bool KN = false> struct EpiBf16 {
    static constexpr bool PERM = true, AFTER_DRAIN = false;
    PG8_GAS bf16_t* O; int ldc; int split_cols; size_t split_stride; const PG8_GAS bf16_t* ps; PG8_GAS float* rvs; int rvs_pn0; PG8_LAS unsigned char* psl;
    __device__ __forceinline__ void pre(const Unit& u, int wid, int lane) const {
#pragma unroll
        for (int i = 0; i < 2; ++i) { const int j = 2 * wid + i;
            __builtin_amdgcn_global_load_lds((const PG8_GAS unsigned*)(ps + ((size_t)(u.pm * BM + 16 * j + (lane >> 2)) * 32 + 8 * (lane & 3))), (PG8_LAS unsigned*)(psl + 1024 * j), 16, 0, 0); }
    }
    __device__ __forceinline__ void operator()(const f32x4 (&acc)[2][2][4][2], const Unit& u, int wr, int wc, int fr, int fq) const {
        const int row0 = u.pm * BM + wr * 64 + fr; int colt = u.pn * BM; PG8_GAS bf16_t* base = O;
        if (split_cols) { const int t = colt / split_cols; base += (size_t)t * split_stride; colt -= t * split_cols; }
        const int col0 = colt + wc * 32 + 8 * fq;
        float rr[2][4];
#pragma unroll
        for (int ai = 0; ai < 2; ++ai)
#pragma unroll
            for (int m = 0; m < 4; ++m) { const u32x4 pv = *(const PG8_LAS u32x4*)(psl + (wr * 64 + fr + ai * HALF + m * 16) * 64 + 16 * fq);
                const float s8 = ((__builtin_bit_cast(float, pv.x << 16) + __builtin_bit_cast(float, pv.x & 0xffff0000u)) + (__builtin_bit_cast(float, pv.y << 16) + __builtin_bit_cast(float, pv.y & 0xffff0000u)))
                               + ((__builtin_bit_cast(float, pv.z << 16) + __builtin_bit_cast(float, pv.z & 0xffff0000u)) + (__builtin_bit_cast(float, pv.w << 16) + __builtin_bit_cast(float, pv.w & 0xffff0000u)));
                rr[ai][m] = __builtin_amdgcn_rsqf(sum_rows4(s8) * (1.0f / 2048.0f) + 1e-6f); }
        const bool do_rvs = RVS && (u.pn >= rvs_pn0);
#pragma unroll
        for (int ai = 0; ai < 2; ++ai)
#pragma unroll
            for (int m = 0; m < 4; ++m) { PG8_GAS bf16_t* rowp = base + (size_t)(row0 + ai * HALF + m * 16) * ldc + col0; const float r = rr[ai][m]; float sq = 0.f; float sk[2] = {0.f, 0.f};
#pragma unroll
                for (int bj = 0; bj < 2; ++bj) { const f32x4 v0 = acc[ai][bj][m][0] * r, v1 = acc[ai][bj][m][1] * r;
                    const float a0 = act_fn<ACT>(v0[0]), a1 = act_fn<ACT>(v0[1]), a2 = act_fn<ACT>(v0[2]), a3 = act_fn<ACT>(v0[3]);
                    const float a4 = act_fn<ACT>(v1[0]), a5 = act_fn<ACT>(v1[1]), a6 = act_fn<ACT>(v1[2]), a7 = act_fn<ACT>(v1[3]);
                    if (RVS) sq += ((a0 * a0 + a1 * a1) + (a2 * a2 + a3 * a3)) + ((a4 * a4 + a5 * a5) + (a6 * a6 + a7 * a7));
                    if (KN) sk[bj] = ((a0 * a0 + a1 * a1) + (a2 * a2 + a3 * a3)) + ((a4 * a4 + a5 * a5) + (a6 * a6 + a7 * a7));
                    u32x4 w; w.x = cvt_pk_bf16(a0, a1); w.y = cvt_pk_bf16(a2, a3); w.z = cvt_pk_bf16(a4, a5); w.w = cvt_pk_bf16(a6, a7);
                    *(PG8_GAS u32x4*)(rowp + bj * HALF) = w; }
                if (RVS) { sq = sum_rows4(sq);
                    if (do_rvs && fq == 0) rvs[(size_t)(row0 + ai * HALF + m * 16) * 32 + (u.pn - rvs_pn0) * 4 + wc] = sq; }
                if (KN) { if (u.pn >= 4 && u.pn < 8) { const float s0 = sum_rows4(sk[0]), s1 = sum_rows4(sk[1]);
                    if (fq == 0) { PG8_GAS float* kp = rvs + (size_t)(row0 + ai * HALF + m * 16) * 32 + (u.pn - 4) * 8 + wc; kp[0] = s0; kp[4] = s1; } } } }
    }
};
template <int MODE> struct EpiRes {
    static constexpr bool PERM = true, AFTER_DRAIN = false;
    const PG8_GAS float* base_lo; const PG8_GAS float* base_hi; int split_row; PG8_GAS float* out; int ldc; PG8_GAS bf16_t* xb; PG8_GAS bf16_t* ps;
    __device__ __forceinline__ void pre(const Unit&, int, int) const {}
    __device__ __forceinline__ void operator()(const f32x4 (&acc)[2][2][4][2], const Unit& u, int wr, int wc, int fr, int fq) const {
        const int row0 = u.pm * BM + wr * 64 + fr, col0 = u.pn * BM + wc * 32 + 8 * fq;
        const PG8_GAS float* bp = (u.pm * BM < split_row) ? base_lo : base_hi;
        u32x4 xv[2][4][2];
        if (MODE != 0) {
#pragma unroll
            for (int ai = 0; ai < 2; ++ai)
#pragma unroll
                for (int m = 0; m < 4; ++m)
#pragma unroll
                    for (int bj = 0; bj < 2; ++bj) xv[ai][m][bj] = *(const PG8_GAS u32x4*)(xb + (size_t)(row0 + ai * HALF + m * 16) * ldc + col0 + bj * HALF);
        }
#pragma unroll
        for (int ai = 0; ai < 2; ++ai)
#pragma unroll
            for (int m = 0; m < 4; ++m) { const size_t off = (size_t)(row0 + ai * HALF + m * 16) * ldc + col0; float sq = 0.f;
#pragma unroll
                for (int bj = 0; bj < 2; ++bj) {
                    f32x4 o0, o1;
                    if (MODE == 0) { o0 = *(const PG8_GAS f32x4*)(bp + off + bj * HALF); o1 = *(const PG8_GAS f32x4*)(bp + off + bj * HALF + 4); }
                    else { const u32x4 x4 = xv[ai][m][bj];
                        o0 = (f32x4){__builtin_bit_cast(float, x4.x << 16), __builtin_bit_cast(float, x4.x & 0xffff0000u), __builtin_bit_cast(float, x4.y << 16), __builtin_bit_cast(float, x4.y & 0xffff0000u)};
                        o1 = (f32x4){__builtin_bit_cast(float, x4.z << 16), __builtin_bit_cast(float, x4.z & 0xffff0000u), __builtin_bit_cast(float, x4.w << 16), __builtin_bit_cast(float, x4.w & 0xffff0000u)}; }
                    o0 += acc[ai][bj][m][0]; o1 += acc[ai][bj][m][1];
                    if (MODE == 2) { *(PG8_GAS f32x4*)(out + off + bj * HALF) = o0; *(PG8_GAS f32x4*)(out + off + bj * HALF + 4) = o1; }
                    else { sq += ((o0[0] * o0[0] + o0[1] * o0[1]) + (o0[2] * o0[2] + o0[3] * o0[3])) + ((o1[0] * o1[0] + o1[1] * o1[1]) + (o1[2] * o1[2] + o1[3] * o1[3]));
                        u32x4 w; w.x = cvt_pk_bf16(o0[0], o0[1]); w.y = cvt_pk_bf16(o0[2], o0[3]); w.z = cvt_pk_bf16(o1[0], o1[1]); w.w = cvt_pk_bf16(o1[2], o1[3]);
                        *(PG8_GAS u32x4*)(xb + off + bj * HALF) = w; } }
                if (MODE != 2) { sq = sum_rows4(sq); if (fq == 0) ps[(size_t)(row0 + ai * HALF + m * 16) * 32 + u.pn * 4 + wc] = (bf16_t)(cvt_pk_bf16(sq, 0.f) & 0xffffu); }
                if (MODE == 0 && (m & 1)) asm volatile("" ::: "memory"); }
    }
};

template <class Epi, class Sched, bool ALIGN_EPI = false, bool SP2 = false>
__device__ __forceinline__ void gemm_phase(PG8_LAS unsigned char* lds, const Gemm g, const Sched& S, const Epi& E) {
    const int tid = g.wbase + lane_id_asm(), wid = __builtin_amdgcn_readfirstlane(tid >> 6), lane = tid & 63, wr = wid >> 2, wc = wid & 3, fr = lane & 15, fq = lane >> 4;
    const int K = g.K, nt = K / BK, LDA = g.lda;
    unsigned voffA, voffB;
    { int R, C; stage_rc(tid * 16, R, C); const int Rb = Epi::PERM ? ((R & ~31) + perm32(R & 31)) : R;
      voffA = (unsigned)(R * LDA + C) * 2u; voffB = (unsigned)(Rb * K + C) * 2u; }
    const size_t s64voffA = (size_t)64 * LDA * 2, s64voffB = (size_t)64 * K * 2;
    const size_t kstep = (size_t)(BK * 2);
    const size_t hstep = (size_t)HALF * K * 2, hstepA = (size_t)HALF * LDA * 2;
    const size_t tstep = 2 * hstep, tstepA = 2 * hstepA;
    const unsigned ldsw = (unsigned)wid * 1024u;
    const int aoff = lds_byte(wr * 64 + fr, fq * 8), boff = lds_byte(wc * 32 + fr, fq * 8);
#define PG8_SA(b, h) (((b) * 2 + (h)) * HTB)
#define PG8_SB(b, h) ((4 + (b) * 2 + (h)) * HTB)
#define PG8_STAGE(bufoff, gbase, voff) do { _Pragma("unroll") for (int _i = 0; _i < 2; ++_i) \
        __builtin_amdgcn_global_load_lds((const unsigned*)((const char*)(gbase) + _i * s64##voff + (voff)), (PG8_LAS unsigned*)(lds + (bufoff) + ldsw + _i * 8192), 16, 0, 0); } while (0)
#define PG8_LDA(dst, b, h) do { _Pragma("unroll") for (int m = 0; m < 4; ++m) _Pragma("unroll") for (int k = 0; k < 2; ++k) dst[m][k] = *(const PG8_LAS bf16x8*)(lds + PG8_SA(b, h) + aoff + m * 2048 + k * 1024); } while (0)
#define PG8_LDB(dst, b, h) do { _Pragma("unroll") for (int n = 0; n < 2; ++n) _Pragma("unroll") for (int k = 0; k < 2; ++k) dst[n][k] = *(const PG8_LAS bf16x8*)(lds + PG8_SB(b, h) + boff + n * 2048 + k * 1024); } while (0)
#define PG8_MMA(ai, bj, At, Bt) do { __builtin_amdgcn_s_setprio(1); _Pragma("unroll") for (int m = 0; m < 4; ++m) _Pragma("unroll") for (int n = 0; n < 2; ++n) _Pragma("unroll") for (int k = 0; k < 2; ++k) \
        acc[ai][bj][m][n] = __builtin_amdgcn_mfma_f32_16x16x32_bf16(Bt[n][k], At[m][k], acc[ai][bj][m][n], 0, 0, 0); __builtin_amdgcn_s_setprio(0); } while (0)
#define PG8_WAIT_V(n) asm volatile("s_waitcnt vmcnt(" #n ")" ::: "memory")
#define PG8_WAIT_L(n) asm volatile("s_waitcnt lgkmcnt(" #n ")" ::: "memory")
#define PG8_BAR __builtin_amdgcn_s_barrier()
#define PG8_SCHED __builtin_amdgcn_sched_barrier(0)
    Unit cur, nxt; int ui = 0;
    if (!S.next(0, cur)) return;
    f32x4 acc[2][2][4][2];
#pragma unroll
    for (int a = 0; a < 2; ++a)
#pragma unroll
        for (int b = 0; b < 2; ++b)
#pragma unroll
            for (int m = 0; m < 4; ++m)
#pragma unroll
                for (int n = 0; n < 2; ++n) acc[a][b][m][n] = zero4();
    bf16x8 At[4][2], B0[2][2], B1[2][2];
    const char* cA = (const char*)g.A + (size_t)cur.pm * tstepA; const char* cB = (const char*)g.Bt + (size_t)cur.pn * tstep;
    S.a_ready(cur);
    if constexpr (SP2) {
        PG8_STAGE(PG8_SB(0, 0), cB, voffB); PG8_STAGE(PG8_SB(0, 1), cB + hstep, voffB); PG8_STAGE(PG8_SA(0, 0), cA, voffA); PG8_STAGE(PG8_SA(0, 1), cA + hstepA, voffA);
        if (wr == 1) PG8_BAR;
        PG8_WAIT_V(2); PG8_BAR;
        PG8_STAGE(PG8_SB(1, 0), cB + kstep, voffB); PG8_STAGE(PG8_SA(1, 0), cA + kstep, voffA); PG8_STAGE(PG8_SB(1, 1), cB + hstep + kstep, voffB);
        PG8_WAIT_V(6); PG8_BAR;
    } else {
        PG8_STAGE(PG8_SB(0, 0), cB, voffB); PG8_STAGE(PG8_SA(0, 0), cA, voffA); PG8_STAGE(PG8_SB(0, 1), cB + hstep, voffB); PG8_STAGE(PG8_SA(0, 1), cA + hstepA, voffA);
        if (wr == 1) PG8_BAR;
        PG8_WAIT_V(4); PG8_BAR;
        PG8_STAGE(PG8_SB(1, 0), cB + kstep, voffB); PG8_STAGE(PG8_SA(1, 0), cA + kstep, voffA); PG8_STAGE(PG8_SB(1, 1), cB + hstep + kstep, voffB);
        PG8_WAIT_V(6); PG8_BAR;
    }
    for (;;) {
        const bool has_next = S.next(ui + 1, nxt);
        const char* nA = has_next ? (const char*)g.A + (size_t)nxt.pm * tstepA : cA; const char* nB = has_next ? (const char*)g.Bt + (size_t)nxt.pn * tstep : cB;
        for (int t = 0; t < nt; t += 2) {
            const bool last = (t == nt - 2);
            const char* a1 = cA + (size_t)(t + 1) * kstep;
            const char* a2 = last ? nA : cA + (size_t)(t + 2) * kstep; const char* b2 = last ? nB : cB + (size_t)(t + 2) * kstep;
            const char* a3 = a2 + kstep; const char* b3 = b2 + kstep;
            if (last && has_next) S.a_ready(nxt);
            if (last) E.pre(cur, wid, lane);
            if constexpr (SP2) {
            PG8_LDB(B0, 0, 0); PG8_LDB(B1, 0, 1); PG8_SCHED; PG8_LDA(At, 0, 0); PG8_STAGE(PG8_SA(1, 1), a1 + hstepA, voffA);
            PG8_WAIT_V(8); PG8_WAIT_L(0); PG8_BAR; PG8_MMA(0, 0, At, B0); PG8_MMA(0, 1, At, B1); PG8_BAR; PG8_SCHED;
            PG8_LDA(At, 0, 1); PG8_STAGE(PG8_SB(0, 0), b2, voffB); PG8_STAGE(PG8_SB(0, 1), b2 + hstep, voffB); PG8_STAGE(PG8_SA(0, 0), a2, voffA);
            PG8_WAIT_V(8); PG8_WAIT_L(0); PG8_BAR; PG8_MMA(1, 0, At, B0); PG8_MMA(1, 1, At, B1); PG8_BAR; PG8_SCHED;
            PG8_LDB(B0, 1, 0); PG8_LDB(B1, 1, 1); PG8_SCHED; PG8_LDA(At, 1, 0); PG8_STAGE(PG8_SA(0, 1), a2 + hstepA, voffA);
            PG8_WAIT_V(8); PG8_WAIT_L(0); PG8_BAR; PG8_MMA(0, 0, At, B0); PG8_MMA(0, 1, At, B1); PG8_BAR; PG8_SCHED;
            PG8_LDA(At, 1, 1); PG8_STAGE(PG8_SB(1, 0), b3, voffB); PG8_STAGE(PG8_SB(1, 1), b3 + hstep, voffB); PG8_STAGE(PG8_SA(1, 0), a3, voffA);
            PG8_WAIT_V(8); PG8_WAIT_L(0); PG8_BAR; PG8_MMA(1, 0, At, B0); PG8_MMA(1, 1, At, B1); PG8_BAR; PG8_SCHED;
            } else {
            PG8_LDB(B0, 0, 0); PG8_SCHED; PG8_LDA(At, 0, 0); PG8_STAGE(PG8_SA(1, 1), a1 + hstepA, voffA);
            PG8_WAIT_L(8); PG8_BAR; PG8_WAIT_L(0); PG8_MMA(0, 0, At, B0); PG8_BAR; PG8_SCHED;
            PG8_LDB(B1, 0, 1); PG8_STAGE(PG8_SB(0, 0), b2, voffB);
            PG8_BAR; PG8_WAIT_L(0); PG8_MMA(0, 1, At, B1); PG8_BAR;
            PG8_LDA(At, 0, 1); PG8_STAGE(PG8_SA(0, 0), a2, voffA);
            PG8_BAR; PG8_WAIT_L(0); PG8_MMA(1, 0, At, B0); PG8_BAR; PG8_SCHED;
            PG8_STAGE(PG8_SB(0, 1), b2 + hstep, voffB);
            PG8_WAIT_V(6); PG8_BAR; PG8_MMA(1, 1, At, B1); PG8_BAR;
            PG8_LDB(B0, 1, 0); PG8_SCHED; PG8_LDA(At, 1, 0); PG8_STAGE(PG8_SA(0, 1), a2 + hstepA, voffA);
            PG8_WAIT_L(8); PG8_BAR; PG8_WAIT_L(0); PG8_MMA(0, 0, At, B0); PG8_BAR; PG8_SCHED;
            PG8_LDB(B1, 1, 1); PG8_STAGE(PG8_SB(1, 0), b3, voffB);
            PG8_BAR; PG8_WAIT_L(0); PG8_MMA(0, 1, At, B1); PG8_BAR;
            PG8_LDA(At, 1, 1); PG8_STAGE(PG8_SA(1, 0), a3, voffA);
            PG8_BAR; PG8_WAIT_L(0); PG8_MMA(1, 0, At, B0); PG8_BAR; PG8_SCHED;
            PG8_STAGE(PG8_SB(1, 1), b3 + hstep, voffB);
            PG8_WAIT_V(6); PG8_BAR; PG8_MMA(1, 1, At, B1); PG8_BAR;
            }
        }
        if constexpr (ALIGN_EPI) { if (wr == 0) PG8_BAR; }
        if constexpr (!Epi::AFTER_DRAIN) { E(acc, cur, wr, wc, fr, fq); S.done(cur); }
        if (!has_next) break;
#pragma unroll
        for (int a = 0; a < 2; ++a)
#pragma unroll
            for (int b = 0; b < 2; ++b)
#pragma unroll
                for (int m = 0; m < 4; ++m)
#pragma unroll
                    for (int n = 0; n < 2; ++n) acc[a][b][m][n] = zero4();
        cur = nxt; cA = nA; cB = nB; ++ui;
        if constexpr (ALIGN_EPI) { if (wr == 1) PG8_BAR; }
    }
    PG8_WAIT_V(0);
    if constexpr (!ALIGN_EPI) { if (wr == 0) PG8_BAR; }
    PG8_BAR;
    if constexpr (Epi::AFTER_DRAIN) { E.fused(acc, cur, wr, wc, fr, fq, lds, wid, lane); S.done(cur); }
#undef PG8_SA
#undef PG8_SB
#undef PG8_STAGE
#undef PG8_LDA
#undef PG8_LDB
#undef PG8_MMA
#undef PG8_WAIT_V
#undef PG8_WAIT_L
#undef PG8_BAR
#undef PG8_SCHED
}
}
constexpr int DM = 2048, NSEQ = 10, SEQL = 4096, M = NSEQ * SEQL, M_PROMPT = 8 * SEQL;
constexpr int DA = 1024, DB = 1024, DH = 128, HA = 8, DFF = 8192, DINAB = 6144, DC2 = 4096, DHALF = 3072;
constexpr int EMB = 33, FO = 64, KLEN = 2 * SEQL, RVF_PITCH = KLEN + 32;
constexpr float EPS = 1e-6f;
constexpr int NWAVES = 8, NTHR = 512;

constexpr size_t MiB = 1u << 20;
constexpr size_t WS_CTL = 0, CTL_ZERO_BYTES = 32 * 1024;
constexpr size_t WS_INVS = 1 * MiB + 768 * 1024;
constexpr size_t WS_WIN = 2 * MiB;
constexpr size_t WS_WOUT = 26 * MiB;
constexpr size_t WS_W1 = 34 * MiB;
constexpr size_t WS_W2 = 66 * MiB;
constexpr size_t WS_FILT = 98 * MiB;
constexpr size_t WS_XB = 130 * MiB;
constexpr size_t WS_BIG = 290 * MiB;
constexpr size_t WS_WIN2 = 930 * MiB;
constexpr size_t WS_WOUT2 = 954 * MiB;
constexpr size_t WS_SSA = 962 * MiB;
constexpr size_t WS_SSB = 968 * MiB;
constexpr size_t WS_RVS = 974 * MiB;
constexpr size_t WS_RVF = 980 * MiB;
constexpr size_t WS_END = 997 * MiB;
constexpr size_t BIG_PA = 0, BIG_PB = 240 * MiB, BIG_UT = 480 * MiB, BIG_X0T = 560 * MiB;

constexpr int CW_BAR = 4096;

constexpr int RING_BYTES = 131072;
constexpr int LDS_BYTES = 163840;
constexpr int MISC_OFF = LDS_BYTES - 128;

#define GAS __attribute__((address_space(1)))
#define LAS __attribute__((address_space(3)))
typedef unsigned short bf16;
typedef unsigned v4u __attribute__((ext_vector_type(4)));
typedef unsigned v2u __attribute__((ext_vector_type(2)));
typedef float f32x4 __attribute__((ext_vector_type(4)));
typedef GAS unsigned gu32;
typedef const GAS float* gcf; typedef GAS float* gf; typedef const GAS unsigned short* gcb; typedef GAS unsigned short* gb;
#define RLX_AGENT __ATOMIC_RELAXED, __HIP_MEMORY_SCOPE_AGENT
#define LDS_WAIT() asm volatile("s_waitcnt lgkmcnt(0)" ::: "memory")
#define VM_WAIT() asm volatile("s_waitcnt vmcnt(0)" ::: "memory")
__device__ __forceinline__ unsigned f2bf(float f) { unsigned u = __builtin_bit_cast(unsigned, f); return (u + 0x7fffu + ((u >> 16) & 1u)) >> 16; }
__device__ __forceinline__ unsigned pk2(float lo, float hi) { unsigned r; asm("v_cvt_pk_bf16_f32 %0, %1, %2" : "=v"(r) : "v"(lo), "v"(hi)); return r; }
__device__ __forceinline__ float bflo(unsigned w) { return __builtin_bit_cast(float, w << 16); }
__device__ __forceinline__ float bfhi(unsigned w) { return __builtin_bit_cast(float, w & 0xffff0000u); }
__device__ __forceinline__ float bf2f(bf16 v) { return __builtin_bit_cast(float, (unsigned)v << 16); }
template <int X> __device__ __forceinline__ float swz_xor(float v) { return __builtin_bit_cast(float, __builtin_amdgcn_ds_swizzle(__builtin_bit_cast(int, v), (X << 10) | 0x1F)); }
__device__ __forceinline__ float half_swap(float v) { const unsigned u = __builtin_bit_cast(unsigned, v); const auto q = __builtin_amdgcn_permlane32_swap(u, u, false, false);
    return __builtin_bit_cast(float, (unsigned)q[0]) + __builtin_bit_cast(float, (unsigned)q[1]) - v; }
__device__ __forceinline__ float wave_sum(float v) {
    v += swz_xor<1>(v); v += swz_xor<2>(v); v += swz_xor<4>(v); v += swz_xor<8>(v); v += swz_xor<16>(v);
    const unsigned u = __builtin_bit_cast(unsigned, v); const auto q = __builtin_amdgcn_permlane32_swap(u, u, false, false);
    return __builtin_bit_cast(float, (unsigned)q[0]) + __builtin_bit_cast(float, (unsigned)q[1]);
}

#define XB_TMO      128
#define XB_XCNT(j)  (256  + 64 * (j))
#define XB_XSUB(j)  (1280 + 64 * (j))
#define XB_XGEN(j)  (2304 + 64 * (j))
#define XB_TOP      3328
#define XB_TOPGEN   3392
#define XCD_BAR_WORDS 3456
#define XB_SPIN_CAP (1u << 22)

__device__ __forceinline__ unsigned xb_ld(unsigned* p)              { return __hip_atomic_load(p, __ATOMIC_RELAXED, __HIP_MEMORY_SCOPE_AGENT); }
__device__ __forceinline__ unsigned xb_add(unsigned* p, unsigned v) { return __hip_atomic_fetch_add(p, v, __ATOMIC_RELAXED, __HIP_MEMORY_SCOPE_AGENT); }
__device__ __forceinline__ unsigned xb_xcc_id() { return (unsigned)__builtin_amdgcn_s_getreg((3 << 11) | 20) & 0xFu; }
#define XB_SPIN(cond, bar) do { unsigned _sp = 0; while (cond) { __builtin_amdgcn_s_sleep(1); \
    if ((++_sp & 255u) == 0u) { if (xb_ld(&(bar)[XB_TMO])) break; if (_sp > XB_SPIN_CAP) { atomicAdd(&(bar)[XB_TMO], 1u); break; } } } } while (0)

struct XcdBarrier {
    unsigned* bar; unsigned x;
    volatile LAS unsigned* st;
};

__device__ __forceinline__ XcdBarrier xcd_barrier_post(unsigned* bar, volatile LAS unsigned* st) {
    XcdBarrier b; b.bar = bar; b.x = xb_xcc_id(); b.st = st;
    if (threadIdx.x == 0) (void)xb_add(&bar[XB_XCNT(b.x)], 1u);
    return b;
}
__device__ __forceinline__ void xcd_barrier_complete(unsigned* bar, unsigned x, unsigned& nloc, unsigned& nx) {
    const unsigned G = gridDim.x * gridDim.y * gridDim.z;
    unsigned sum, cnt, mine, sp = 0u;
    for (;;) {
        sum = 0u; cnt = 0u; mine = 0u;
#pragma unroll
        for (unsigned j = 0; j < 16; ++j) { const unsigned c = xb_ld(&bar[XB_XCNT(j)]); sum += c; cnt += (c > 0u) ? 1u : 0u; mine = (j == x) ? c : mine; }
        if (sum == G) break;
        __builtin_amdgcn_s_sleep(1);
        if ((++sp & 255u) == 0u) { if (xb_ld(&bar[XB_TMO])) break; if (sp > XB_SPIN_CAP) { atomicAdd(&bar[XB_TMO], 1u); break; } }
    }
    nloc = mine > 0u ? mine : 1u; nx = cnt > 0u ? cnt : 1u;
}

__device__ __forceinline__ void xcd_barrier(const XcdBarrier& b) {
    asm volatile("s_waitcnt vmcnt(0)" ::: "memory");
    __syncthreads();
    if (threadIdx.x == 0) {
        unsigned* bar = b.bar;
        __builtin_amdgcn_s_waitcnt(0);
        unsigned nloc = b.st[0], nx = b.st[1];
        if (nloc == 0u) { xcd_barrier_complete(bar, b.x, nloc, nx); b.st[0] = nloc; b.st[1] = nx; }
        const unsigned old = xb_add(&bar[XB_XSUB(b.x)], 1u);
        const unsigned gen = old / nloc;
        if (old + 1u == (gen + 1u) * nloc) {
            __builtin_amdgcn_fence(__ATOMIC_RELEASE, "agent");
            asm volatile("s_waitcnt vmcnt(0)" ::: "memory");
            const unsigned og = xb_add(&bar[XB_TOP], 1u);
            const unsigned tg = og / nx;
            if (og + 1u == (tg + 1u) * nx) xb_add(&bar[XB_TOPGEN], 1u);
            else XB_SPIN(xb_ld(&bar[XB_TOPGEN]) == tg, bar);
            __builtin_amdgcn_fence(__ATOMIC_ACQUIRE, "agent");
            xb_add(&bar[XB_XGEN(b.x)], 1u);
            asm volatile("s_waitcnt vmcnt(0)" ::: "memory");
        } else {
            XB_SPIN(xb_ld(&bar[XB_XGEN(b.x)]) == gen, bar);
            __builtin_amdgcn_fence(__ATOMIC_ACQUIRE, "agent");
            asm volatile("s_waitcnt vmcnt(0)" ::: "memory");
        }
    }
    __syncthreads();
}


struct Frame {
    LAS unsigned char* lds;
    volatile LAS unsigned* MISC;
    gu32* ctl;
    int tid, lane, wave;
    int vcu, G, bx, wbase;
    gcf xp, xs; gf out;
    GAS unsigned char* ws;
    gb W1, W2, XB;
    gf FILT, RVS, INVS; gb RVF, SSA, SSB;
};
struct Params { const float* in[27]; float* out; unsigned char* ws; int ph_lo, ph_hi; };

__device__ __forceinline__ gcf xrow_ptr(const Frame& F, int layer, int m) {
    if (layer == 0) return m < M_PROMPT ? F.xp + (size_t)m * DM : F.xs + (size_t)(m - M_PROMPT) * DM;
    return F.out + (size_t)m * DM;
}

__device__ __forceinline__ void xb_rows(Frame& F) {
    const int gw = F.vcu * NWAVES + F.wave, NGW = F.G * NWAVES;
    for (int m = gw; m < M; m += NGW) {
        const GAS f32x4* xr = (const GAS f32x4*)xrow_ptr(F, 0, m) + F.lane;
        f32x4 v[8]; float s = 0.f;
#pragma unroll
        for (int j = 0; j < 8; ++j) { v[j] = xr[64 * j]; s += (v[j].x * v[j].x + v[j].y * v[j].y) + (v[j].z * v[j].z + v[j].w * v[j].w); }
        s = wave_sum(s);
        GAS unsigned long long* o8 = (GAS unsigned long long*)(F.XB + (size_t)m * DM) + F.lane;
#pragma unroll
        for (int j = 0; j < 8; ++j) o8[64 * j] = (unsigned long long)pk2(v[j].x, v[j].y) | ((unsigned long long)pk2(v[j].z, v[j].w) << 32);
        { const float h0 = bfhi(pk2(0.f, s)), h1 = bfhi(pk2(0.f, s - h0)), h2 = s - h0 - h1;
          if (F.lane < 32) F.SSA[(size_t)m * 32 + F.lane] = (bf16)(pk2(F.lane == 0 ? h0 : (F.lane == 1 ? h1 : (F.lane == 2 ? h2 : 0.f)), 0.f) & 0xffffu); }
    }
}
__device__ __forceinline__ void zero_f32(Frame& F, gf p, int n) {
    for (int i = F.vcu * NTHR + F.tid; i < n / 4; i += F.G * NTHR) ((GAS f32x4*)p)[i] = pg8::zero4();
}
__device__ __forceinline__ void transpose_item(gcf W, gcf gain, int K, int N, gb WT, LAS float* scr, int item, int lane) {
    const int nblk = N / 64, kb = item / nblk, nb = item % nblk, k0 = 64 * kb, n0 = 64 * nb;
    const int lr = lane >> 4, lc = lane & 15;
    f32x4 v[16];
#pragma unroll
    for (int i = 0; i < 16; ++i) v[i] = *(const GAS f32x4*)(W + (size_t)(k0 + 4 * i + lr) * N + n0 + 4 * lc);
    float gk[16];
    if (gain) {
#pragma unroll
        for (int i = 0; i < 16; ++i) gk[i] = gain[k0 + 4 * i + lr];
    } else {
#pragma unroll
        for (int i = 0; i < 16; ++i) gk[i] = 1.0f;
    }
#pragma unroll
    for (int i = 0; i < 16; ++i) asm volatile("" : "+v"(gk[i]));
#pragma unroll
    for (int i = 0; i < 16; ++i) *(LAS f32x4*)(scr + (4 * i + lr) * 68 + 4 * lc) = v[i] * gk[i];
    LDS_WAIT(); asm volatile("" ::: "memory");
    const int kc = lane & 7, nr = lane >> 3;
#pragma unroll
    for (int j = 0; j < 8; ++j) { const int n = 8 * j + nr; const LAS float* s = scr + (8 * kc) * 68 + n;
        v4u o; o.x = pk2(s[0 * 68], s[1 * 68]); o.y = pk2(s[2 * 68], s[3 * 68]); o.z = pk2(s[4 * 68], s[5 * 68]); o.w = pk2(s[6 * 68], s[7 * 68]);
        *(GAS v4u*)(WT + (size_t)(n0 + n) * K + k0 + 8 * kc) = o; }
    LDS_WAIT(); asm volatile("" ::: "memory");
}
struct CvtJob { gcf W; gcf gain; gb T; int K, N; };
template <int NJ> __device__ __forceinline__ void convert_jobs(Frame& F, const CvtJob (&jobs)[NJ], int lds_off) {
    LAS float* scr = (LAS float*)(F.lds + lds_off + F.wave * 17408);
    const int gw = F.vcu * NWAVES + F.wave, NGW = F.G * NWAVES;
    int total = 0;
#pragma unroll
    for (int q = 0; q < NJ; ++q) total += (jobs[q].K / 64) * (jobs[q].N / 64);
    for (int it = gw; it < total; it += NGW) {
        int r = it;
#pragma unroll
        for (int q = 0; q < NJ; ++q) { const int I = (jobs[q].K / 64) * (jobs[q].N / 64);
            if (r >= 0 && r < I) transpose_item(jobs[q].W, jobs[q].gain, jobs[q].K, jobs[q].N, jobs[q].T, scr, r, F.lane);
            r -= I; }
    }
}

template <class P> __device__ __forceinline__ P unif_ptr(P p) { const unsigned long long v = (unsigned long long)p;
    const unsigned lo = __builtin_amdgcn_readfirstlane((unsigned)v), hi = __builtin_amdgcn_readfirstlane((unsigned)(v >> 32)); return (P)(((unsigned long long)hi << 32) | lo); }
__device__ __forceinline__ void filter_gen(Frame& F, gcf fw1v, gcf fb1v, gcf fw2v, gcf fb2v, gcf fw3v, gcf fb3v,
                                           gcf fwoutv, gcf ffreqv) {
    gcf fw1 = unif_ptr(fw1v), fb1 = unif_ptr(fb1v), fw2 = unif_ptr(fw2v), fb2 = unif_ptr(fb2v), fw3 = unif_ptr(fw3v), fb3 = unif_ptr(fb3v), fwout = unif_ptr(fwoutv), ffreq = unif_ptr(ffreqv);
    LAS float* zf = (LAS float*)(F.lds);
    LAS float* ha = zf + 16 * 36;
    LAS float* hb = ha + 16 * 64;
    for (int unit = F.bx; unit < SEQL / 16; unit += F.G) {
        const int t0 = unit * 16;
        __syncthreads();
        for (int e = F.tid; e < 16 * EMB; e += NTHR) {
            const int tl = e / EMB, k = e % EMB, t = t0 + tl;
            const float tlin = (float)t / (float)(SEQL - 1);
            const float w = 6.283185307179586f * (float)t / (float)SEQL;
            float z;
            if (k == 0) z = tlin;
            else { const int kk = (k - 1) & 15; const float fk = 1e-4f + (float)kk * ((15.0f - 1e-4f) / 15.0f); z = (k <= 16) ? cosf(fk * w) : -sinf(fk * w); }
            zf[tl * 36 + k] = z;
        }
        __syncthreads();
        for (int e = F.tid; e < 16 * FO; e += NTHR) {
            const int tl = e / FO, o = e % FO; float s = fb1[o];
            static_assert(EMB % 11 == 0 && FO % 16 == 0, "filter MLP load batches");
            for (int k0 = 0; k0 < EMB; k0 += 11) { float wv[11];
#pragma unroll
                for (int j = 0; j < 11; ++j) wv[j] = fw1[(k0 + j) * FO + o];
#pragma unroll
                for (int j = 0; j < 11; ++j) asm volatile("" : "+v"(wv[j]));
#pragma unroll
                for (int j = 0; j < 11; ++j) s += zf[tl * 36 + k0 + j] * wv[j]; }
            ha[tl * FO + o] = sinf(ffreq[o] * s);
        }
        __syncthreads();
        for (int e = F.tid; e < 16 * FO; e += NTHR) {
            const int tl = e / FO, o = e % FO; float s = fb2[o];
            for (int k0 = 0; k0 < FO; k0 += 16) { float wv[16];
#pragma unroll
                for (int j = 0; j < 16; ++j) wv[j] = fw2[(k0 + j) * FO + o];
#pragma unroll
                for (int j = 0; j < 16; ++j) asm volatile("" : "+v"(wv[j]));
#pragma unroll
                for (int j = 0; j < 16; ++j) s += ha[tl * FO + k0 + j] * wv[j]; }
            hb[tl * FO + o] = sinf(ffreq[o] * s);
        }
        __syncthreads();
        for (int e = F.tid; e < 16 * FO; e += NTHR) {
            const int tl = e / FO, o = e % FO; float s = fb3[o];
            for (int k0 = 0; k0 < FO; k0 += 16) { float wv[16];
#pragma unroll
                for (int j = 0; j < 16; ++j) wv[j] = fw3[(k0 + j) * FO + o];
#pragma unroll
                for (int j = 0; j < 16; ++j) asm volatile("" : "+v"(wv[j]));
#pragma unroll
                for (int j = 0; j < 16; ++j) s += hb[tl * FO + k0 + j] * wv[j]; }
            ha[o * 16 + tl] = sinf(ffreq[o] * s);
        }
        __syncthreads();
        for (int q = 0; q < 4; ++q) {
            const int o = F.tid + NTHR * q;
            float acc[16];
#pragma unroll
            for (int i = 0; i < 16; ++i) acc[i] = 0.f;
            for (int k0 = 0; k0 < FO; k0 += 16) { float wq[16];
#pragma unroll
              for (int j = 0; j < 16; ++j) wq[j] = fwout[(k0 + j) * (2 * DB) + o];
#pragma unroll
              for (int j = 0; j < 16; ++j) asm volatile("" : "+v"(wq[j]));
#pragma unroll
              for (int j = 0; j < 16; ++j) { const int k = k0 + j; const float wv = wq[j];
                const f32x4 h0 = *(const LAS f32x4*)(ha + k * 16), h1 = *(const LAS f32x4*)(ha + k * 16 + 4), h2 = *(const LAS f32x4*)(ha + k * 16 + 8), h3 = *(const LAS f32x4*)(ha + k * 16 + 12);
                acc[0] += h0[0] * wv; acc[1] += h0[1] * wv; acc[2] += h0[2] * wv; acc[3] += h0[3] * wv; acc[4] += h1[0] * wv; acc[5] += h1[1] * wv; acc[6] += h1[2] * wv; acc[7] += h1[3] * wv;
                acc[8] += h2[0] * wv; acc[9] += h2[1] * wv; acc[10] += h2[2] * wv; acc[11] += h2[3] * wv; acc[12] += h3[0] * wv; acc[13] += h3[1] * wv; acc[14] += h3[2] * wv; acc[15] += h3[3] * wv; } }
            const int c = o & (DB - 1);
            const float dlo = -15.350567286626973f, dhi = -3.0701134573253945f;
            const float delta = fabsf(dlo + (float)c * ((dhi - dlo) / (float)(DB - 1)));
            gf frow = F.FILT + (size_t)c * KLEN;
            gb rrow = F.RVF + (size_t)c * RVF_PITCH;
#pragma unroll
            for (int i = 0; i < 16; ++i) { const int t = t0 + i; const float tlin = (float)t / (float)(SEQL - 1); const float v = acc[i] * expf(-tlin * delta);
                if (o < DB) { frow[t] = v; rrow[SEQL - t] = (bf16)f2bf(v); } else if (t > 0) { frow[KLEN - t] = v; rrow[SEQL + t] = (bf16)f2bf(v); } else { frow[SEQL] = 0.f; rrow[0] = 0; } }
            if (unit == 0 && o < DB) {
#pragma unroll
                for (int i = 0; i < 32; ++i) rrow[KLEN + i] = 0;
            }
        }
    }
}

struct PrepRegs { v4u x[3][3]; };
__device__ __forceinline__ void prep_load(PrepRegs& R, gcb PB, int cb, int bt, int tl, int cv) {
    const int b = bt >> 6, tb = bt & 63, t = tb * 64 + tl, c = cb * 64 + 8 * cv;
    gcb p = PB + ((size_t)b * SEQL + t) * DHALF + c;
#pragma unroll
    for (int part = 0; part < 3; ++part) {
        R.x[part][0] = (t > 0) ? *(const GAS v4u*)(p + part * DB - DHALF) : (v4u){0u, 0u, 0u, 0u};
        R.x[part][1] = *(const GAS v4u*)(p + part * DB);
        R.x[part][2] = (t < SEQL - 1) ? *(const GAS v4u*)(p + part * DB + DHALF) : (v4u){0u, 0u, 0u, 0u};
    }
}
struct PrepW { f32x4 w[3][2]; f32x4 b[2]; };
__device__ __forceinline__ void prep_weights(PrepW& W, gcf scw, gcf scb, int col) {
#pragma unroll
    for (int k = 0; k < 3; ++k) { W.w[k][0] = *(const GAS f32x4*)(scw + k * DHALF + col); W.w[k][1] = *(const GAS f32x4*)(scw + k * DHALF + col + 4); }
    W.b[0] = *(const GAS f32x4*)(scb + col); W.b[1] = *(const GAS f32x4*)(scb + col + 4);
}
__device__ __forceinline__ void conv8(float (&z)[8], const v4u (&x)[3], const PrepW& W) {
#pragma unroll
    for (int e = 0; e < 8; ++e) z[e] = (e < 4) ? W.b[0][e] : W.b[1][e - 4];
#pragma unroll
    for (int k = 0; k < 3; ++k) { const v4u v = x[k];
        z[0] += bflo(v.x) * W.w[k][0][0]; z[1] += bfhi(v.x) * W.w[k][0][1]; z[2] += bflo(v.y) * W.w[k][0][2]; z[3] += bfhi(v.y) * W.w[k][0][3];
        z[4] += bflo(v.z) * W.w[k][1][0]; z[5] += bfhi(v.z) * W.w[k][1][1]; z[6] += bflo(v.w) * W.w[k][1][2]; z[7] += bfhi(v.w) * W.w[k][1][3]; }
}
__device__ __forceinline__ void hyena_prep(Frame& F, gcb PB, gb UT, gb X0T, gcf scw, gcf scb) {
    LAS bf16* tu = (LAS bf16*)(F.lds);
    LAS bf16* tx = tu + 64 * 72;
    const int tl = F.tid >> 3, cv = F.tid & 7;
    const int NBT = NSEQ * 64, nb = F.G >> 4, cb = F.bx & 15;
    if ((F.G & 15) != 0 || nb == 0) return;
    PrepW W0, W1, W2;
    prep_weights(W0, scw, scb, cb * 64 + 8 * cv); prep_weights(W1, scw, scb, DB + cb * 64 + 8 * cv); prep_weights(W2, scw, scb, 2 * DB + cb * 64 + 8 * cv);
    int bt = F.bx >> 4;
    PrepRegs R;
    if (bt < NBT) prep_load(R, PB, cb, bt, tl, cv);
    for (; bt < NBT; bt += nb) {
        float z0[8], z1[8], z2[8];
        conv8(z0, R.x[0], W0); conv8(z1, R.x[1], W1); conv8(z2, R.x[2], W2);
        if (bt + nb < NBT) prep_load(R, PB, cb, bt + nb, tl, cv);
        __syncthreads();
#pragma unroll
        for (int e = 0; e < 8; ++e) { tu[(8 * cv + e) * 72 + tl] = (bf16)f2bf(z2[e] * z1[e]); tx[(8 * cv + e) * 72 + tl] = (bf16)f2bf(z0[e]); }
        __syncthreads();
        const int cl = F.tid >> 3, tc = F.tid & 7, b = bt >> 6, tb = bt & 63;
        const size_t o = ((size_t)(cb * 64 + cl) * NSEQ + b) * SEQL + tb * 64 + 8 * tc;
        *(GAS v4u*)(UT + o) = *(const LAS v4u*)(tu + cl * 72 + 8 * tc);
        *(GAS v4u*)(X0T + o) = *(const LAS v4u*)(tx + cl * 72 + 8 * tc);
    }
}
__device__ __forceinline__ void filter_norm(Frame& F) {
    const int gw = F.vcu * NWAVES + F.wave, NGW = F.G * NWAVES;
    for (int c = gw; c < DB; c += NGW) {
        const GAS f32x4* p = (const GAS f32x4*)(F.FILT + (size_t)c * KLEN) + F.lane; float s = 0.f;
        for (int j0 = 0; j0 < KLEN / 256; j0 += 16) { f32x4 v[16];
#pragma unroll
            for (int j = 0; j < 16; ++j) v[j] = p[64 * (j0 + j)];
#pragma unroll
            for (int j = 0; j < 16; ++j) asm volatile("" : "+v"(v[j]));
#pragma unroll
            for (int j = 0; j < 16; ++j) s += (fabsf(v[j].x) + fabsf(v[j].y)) + (fabsf(v[j].z) + fabsf(v[j].w)); }
        s = wave_sum(s);
        if (F.lane == 0) F.INVS[c] = 1.f / s;
    }
}
constexpr int HY_C_OFF = 92416;
constexpr int HY_CS = 8704;
constexpr int HY_Z_OFF = HY_C_OFF + 8 * HY_CS;
static_assert(HY_Z_OFF + 128 <= MISC_OFF, "hyena LDS map");
typedef short bf16x8_t __attribute__((ext_vector_type(8)));
template <bool PRE>
__device__ __forceinline__ void hyena_build_copies(Frame& F, gcb rv, int zmin, int nz, v4u A0 = (v4u){0u, 0u, 0u, 0u}, v4u B0 = (v4u){0u, 0u, 0u, 0u}) {
    for (int zi = F.tid; zi < nz; zi += NTHR) {
        gcb p = rv + SEQL + zmin + 8 * zi;
        v4u A, B;
        if (PRE && zi < NTHR) { A = A0; B = B0; } else { A = *(const GAS v4u*)p; B = *(const GAS v4u*)(p + 8); }
        const unsigned d[8] = {A.x, A.y, A.z, A.w, B.x, B.y, B.z, B.w};
#pragma unroll
        for (int s = 0; s < 8; ++s) {
            v4u o;
            if ((s & 1) == 0) { o.x = d[s / 2]; o.y = d[s / 2 + 1]; o.z = d[s / 2 + 2]; o.w = d[s / 2 + 3]; }
            else { const int q = (s - 1) / 2;
                o.x = __builtin_amdgcn_alignbit(d[q + 1], d[q], 16); o.y = __builtin_amdgcn_alignbit(d[q + 2], d[q + 1], 16);
                o.z = __builtin_amdgcn_alignbit(d[q + 3], d[q + 2], 16); o.w = __builtin_amdgcn_alignbit(d[q + 4], d[q + 3], 16); }
            *(LAS v4u*)(F.lds + HY_C_OFF + s * HY_CS + 16 * ((0xC0B6E590u >> (4 * s)) & 15u) + 16 * zi) = o;
        }
    }
}
__device__ __forceinline__ void hyena_conv_mfma(Frame& F, gcb UT, gcb X0T, gb GT, gcf hbias) {
    const int lane = F.lane, w = F.wave, m = lane & 15, g = lane >> 4;
    const int sh = (-m) & 7, cc = (m + 7) >> 3;
    const unsigned copyb = HY_C_OFF + sh * HY_CS + 16 * ((0xC0B6E590u >> (4 * sh)) & 15u);
    const int pb = 14 - 2 * w, sb = 8 * w;
    const int dP = m >> 3, dS = m >> 1;
    const unsigned laneBP = (m & 7) * 8192 + 16 * (g ^ (m & 7)), laneBS = (8 + (m & 1)) * 8192, gxS = 16 * (g ^ (m & 1));
    const unsigned zb = HY_Z_OFF + 16 * g;
    for (int c = F.bx; c < DB; c += F.G) {
        gcb rvc = F.RVF + (size_t)c * RVF_PITCH;
        __syncthreads();
        if (F.tid < 8) *(LAS f32x4*)(F.lds + HY_Z_OFF + 16 * F.tid) = pg8::zero4();
        v4u rA, rB;
        { const GAS v4u* src = (const GAS v4u*)(UT + (size_t)c * NSEQ * SEQL);
          int ts = F.tid; asm volatile("" : "+v"(ts));
          const unsigned blk = ts >> 3, chk = ts & 7, fs = ((blk >> 1) & 3) << 1;
          v4u ur[NSEQ];
#pragma unroll
          for (int b = 0; b < NSEQ; ++b) ur[b] = src[b * 512 + ts];
          rA = *(const GAS v4u*)(rvc + SEQL - 4096 + 8 * ts); rB = *(const GAS v4u*)(rvc + SEQL - 4096 + 8 * ts + 8);
          __builtin_amdgcn_sched_barrier(0);
#pragma unroll
          for (int b = 0; b < NSEQ; ++b) { const unsigned f = (b < 8) ? (unsigned)b : ((unsigned)(b & 1) ^ fs); *(LAS v4u*)(F.lds + b * 8192 + blk * 128 + 16 * (chk ^ f)) = ur[b]; } }
        hyena_build_copies<true>(F, rvc, -4096, 520, rA, rB);
        __syncthreads();
        f32x4 acc[5][4];
#pragma unroll
        for (int i = 0; i < 5; ++i)
#pragma unroll
            for (int mt = 0; mt < 4; ++mt) acc[i][mt] = pg8::zero4();
        bf16x8_t A[4][2], An[4][2];
        v4u Bc0, Bc1, Bn0, Bn1, Bs0, Bs1;
#define HY_LDA(dst, base) do { _Pragma("unroll") for (int mt = 0; mt < 4; ++mt) _Pragma("unroll") for (int ks = 0; ks < 2; ++ks) \
            dst[mt][ks] = *(const LAS bf16x8_t*)(F.lds + (base) + (96 - 32 * mt + 64 * ks)); } while (0)
#define HY_LPC(buf, ap) do { const int ab_ = (ap) + dP; const unsigned bo_ = ((unsigned)ab_ < 64u) ? laneBP + 128u * (unsigned)ab_ : zb; \
            buf##0 = *(const LAS v4u*)(F.lds + bo_); buf##1 = *(const LAS v4u*)(F.lds + (bo_ ^ 64u)); __builtin_amdgcn_sched_barrier(0); } while (0)
#define HY_LPU(buf, off) do { buf##0 = *(const LAS v4u*)(F.lds + bq0 + (off)); buf##1 = *(const LAS v4u*)(F.lds + bq1 + (off)); __builtin_amdgcn_sched_barrier(0); } while (0)
#define HY_LS(buf, ap) do { const int ab_ = (ap) + dS; const unsigned bo_ = ((unsigned)ab_ < 64u) ? laneBS + 128u * (unsigned)ab_ + (gxS ^ (((unsigned)ab_ << 4) & 0x60u)) : zb; \
            buf##0 = *(const LAS v4u*)(F.lds + bo_); buf##1 = *(const LAS v4u*)(F.lds + (bo_ ^ 64u)); } while (0)
#define HY_MM(AA, i, buf) do { const bf16x8_t B0_ = __builtin_bit_cast(bf16x8_t, buf##0), B1_ = __builtin_bit_cast(bf16x8_t, buf##1); \
            _Pragma("unroll") for (int mt = 0; mt < 4; ++mt) acc[i][mt] = __builtin_amdgcn_mfma_f32_16x16x32_bf16(AA[mt][0], B0_, acc[i][mt], 0, 0, 0); \
            _Pragma("unroll") for (int mt = 0; mt < 4; ++mt) acc[i][mt] = __builtin_amdgcn_mfma_f32_16x16x32_bf16(AA[mt][1], B1_, acc[i][mt], 0, 0, 0); } while (0)
        {
            const unsigned laneA0 = copyb + 16 * g - 16 * cc + 8192 - 96;
            const int limS = sb + 7;
            int E = 0;
            HY_LDA(A, laneA0);
            HY_LPC(Bc, pb + 48);
            unsigned bq0 = laneBP + 128u * (unsigned)(pb + 15 + dP), bq1 = bq0 ^ 64u;
#define HY_TOP(Y, E_) HY_LDA(Y, laneA0 - 128 * min((E_) + 1, 63)); const bool sa_ = (E_) <= limS; if (sa_) HY_LS(Bs, sb - (E_))
#define HY_END(X) if (sa_) HY_MM(X, 4, Bs)
#define HY_DEC bq0 -= 128u; bq1 -= 128u
#define HY_S0(X, Y, P, Q, E_) { HY_TOP(Y, E_); HY_LPU(Q, 2176); HY_MM(X, 3, P); HY_LPU(P, 128); HY_MM(X, 2, Q); HY_LPC(Q, pb - (E_)); HY_MM(X, 1, P); HY_LPU(P, 4096); HY_MM(X, 0, Q); HY_END(X); HY_DEC; }
#define HY_S1(X, Y, P, Q, E_) { HY_TOP(Y, E_); HY_LPU(Q, 128); HY_MM(X, 3, P); HY_LPC(P, pb + 16 - (E_)); HY_MM(X, 2, Q); HY_LPU(Q, 2048); HY_MM(X, 1, P); HY_END(X); HY_DEC; }
#define HY_S2(X, Y, P, Q, E_) { HY_TOP(Y, E_); HY_LPC(Q, pb + 32 - (E_)); HY_MM(X, 3, P); HY_LPU(P, 0); HY_MM(X, 2, Q); HY_END(X); HY_DEC; }
#define HY_S3(X, Y, P, Q, E_) { HY_TOP(Y, E_); HY_LPC(Q, pb + 47 - (E_)); HY_MM(X, 3, P); HY_END(X); }
#define HY_ST(X, Y, P, Q, E_) { HY_LDA(Y, laneA0 - 128 * min((E_) + 1, 63)); HY_LS(Q, sb - (E_) - 1); HY_MM(X, 4, P); }
            for (; E <= pb + 1; E += 2) { HY_S0(A, An, Bc, Bn, E) HY_S0(An, A, Bc, Bn, E + 1) }
            bq0 += 2048u; bq1 += 2048u;
            for (; E <= pb + 17; E += 2) { HY_S1(A, An, Bc, Bn, E) HY_S1(An, A, Bn, Bc, E + 1) }
            bq0 += 2048u; bq1 += 2048u;
            for (; E <= pb + 33; E += 2) { HY_S2(A, An, Bc, Bn, E) HY_S2(An, A, Bc, Bn, E + 1) }
            for (; E <= pb + 49; E += 2) { HY_S3(A, An, Bc, Bn, E) HY_S3(An, A, Bn, Bc, E + 1) }
            HY_LS(Bc, sb - E);
            for (; E <= limS; E += 2) { HY_ST(A, An, Bc, Bn, E) HY_ST(An, A, Bn, Bc, E + 1) }
#undef HY_TOP
#undef HY_DEC
#undef HY_S0
#undef HY_S1
#undef HY_S2
#undef HY_S3
#undef HY_ST
        }
        __syncthreads();
          hyena_build_copies<false>(F, rvc, 0, 512);
        __syncthreads();
        {
            const unsigned laneA0 = copyb + 16 * g - 16 * cc - 96;
            const int limS = 63 - sb;
            int e = 1;
            HY_LDA(An, laneA0 + 128);
            HY_LPC(Bc, pb + 1);
            unsigned bq0 = laneBP + 128u * (unsigned)(pb + 1 + dP), bq1 = bq0 ^ 64u;
#define HY_TOP(Y, e_) HY_LDA(Y, laneA0 + 128 * min((e_) + 1, 63)); const bool sa_ = (e_) <= limS; if (sa_) HY_LS(Bs, sb + (e_))
#define HY_INC bq0 += 128u; bq1 += 128u
#define HY_P0(X, Y, P, Q, e_) { HY_TOP(Y, e_); HY_LPU(Q, 2048); HY_MM(X, 0, P); HY_LPU(P, 4096); HY_MM(X, 1, Q); HY_LPC(Q, pb + 48 + (e_)); HY_MM(X, 2, P); HY_LPU(P, 128); HY_MM(X, 3, Q); HY_END(X); HY_INC; }
#define HY_P1(X, Y, P, Q, e_) { HY_TOP(Y, e_); HY_LPU(Q, 2048); HY_MM(X, 0, P); HY_LPC(P, pb + 32 + (e_)); HY_MM(X, 1, Q); HY_LPU(Q, 128); HY_MM(X, 2, P); HY_END(X); HY_INC; }
#define HY_P2(X, Y, P, Q, e_) { HY_TOP(Y, e_); HY_LPC(Q, pb + 16 + (e_)); HY_MM(X, 0, P); HY_LPU(P, 128); HY_MM(X, 1, Q); HY_END(X); HY_INC; }
#define HY_P3(X, Y, P, Q, e_) { HY_TOP(Y, e_); HY_LPC(Q, pb + 1 + (e_)); HY_MM(X, 0, P); HY_END(X); }
#define HY_PT(X, Y, P, Q, e_) { HY_LDA(Y, laneA0 + 128 * min((e_) + 1, 63)); HY_LS(Q, sb + (e_) + 1); HY_MM(X, 4, P); }
            HY_P0(An, A, Bc, Bn, e) ++e;
            for (; e <= 15 - pb; e += 2) { HY_P0(A, An, Bc, Bn, e) HY_P0(An, A, Bc, Bn, e + 1) }
            for (; e <= 31 - pb; e += 2) { HY_P1(A, An, Bc, Bn, e) HY_P1(An, A, Bn, Bc, e + 1) }
            for (; e <= 47 - pb; e += 2) { HY_P2(A, An, Bc, Bn, e) HY_P2(An, A, Bc, Bn, e + 1) }
            for (; e <= 63 - pb; e += 2) { HY_P3(A, An, Bc, Bn, e) HY_P3(An, A, Bn, Bc, e + 1) }
            HY_LS(Bc, sb + e);
            for (; e <= limS; e += 2) { HY_PT(A, An, Bc, Bn, e) HY_PT(An, A, Bn, Bc, e + 1) }
#undef HY_TOP
#undef HY_INC
#undef HY_P0
#undef HY_P1
#undef HY_P2
#undef HY_P3
#undef HY_PT
        }
#undef HY_END
#undef HY_LDA
#undef HY_LPC
#undef HY_LPU
#undef HY_LS
#undef HY_MM
        {
            const float is = F.INVS[c], hb = hbias[c];
            int le = F.lane; asm volatile("" : "+v"(le));
            const int m = le & 15, g = le >> 4, dP = m >> 3, dS = m >> 1;
            const int sblk = sb + dS;
            const size_t oP = ((size_t)c * NSEQ + (m & 7)) * SEQL + 64 * (pb + dP) + 4 * g, oS = ((size_t)c * NSEQ + 8 + (m & 1)) * SEQL + 64 * sblk + 4 * g;
            const unsigned uPo = (m & 7) * 8192 + (pb + dP) * 128 + 8 * (g & 1), qP = 16 * ((g >> 1) ^ (m & 7));
            const unsigned uSo = (8 + (m & 1)) * 8192 + sblk * 128 + 8 * (g & 1), qS = 16 * ((g >> 1) ^ (m & 1) ^ (((sblk >> 1) & 3) << 1));
            v2u xq[5][4];
#pragma unroll
            for (int i = 0; i < 5; ++i)
#pragma unroll
                for (int mt = 0; mt < 4; ++mt) xq[i][mt] = *(const GAS v2u*)(X0T + ((i < 4) ? oP + 1024 * i + 16 * mt : oS + 16 * mt));
            __builtin_amdgcn_sched_barrier(0);
#pragma unroll
            for (int i = 0; i < 5; ++i)
#pragma unroll
                for (int mt = 0; mt < 4; ++mt) {
                    const size_t o = (i < 4) ? oP + 1024 * i + 16 * mt : oS + 16 * mt;
                    const unsigned up = (i < 4) ? uPo + 2048 * i + (qP ^ (32 * mt)) : uSo + (qS ^ (32 * mt));
                    const v2u xv = xq[i][mt];
                    const v2u uv = *(const LAS v2u*)(F.lds + up);
                    const f32x4 a4 = acc[i][mt];
                    const float y0 = (a4.x * is + bflo(uv.x) * hb) * bflo(xv.x), y1 = (a4.y * is + bfhi(uv.x) * hb) * bfhi(xv.x);
                    const float y2 = (a4.z * is + bflo(uv.y) * hb) * bflo(xv.y), y3 = (a4.w * is + bfhi(uv.y) * hb) * bfhi(xv.y);
                    *(GAS v2u*)(GT + o) = (v2u){pk2(y0, y1), pk2(y2, y3)};
                }
        }
    }
}
__device__ __forceinline__ void hyena_post(Frame& F, gcb GT, gb O, int ldo) {
    LAS bf16* tl_ = (LAS bf16*)(F.lds);
    for (int unit = F.bx; unit < NSEQ * 64 * 16; unit += F.G) {
        const int cb = unit / (NSEQ * 64), rem = unit % (NSEQ * 64), b = rem >> 6, tb = rem & 63;
        const int cl = F.tid >> 3, tc = F.tid & 7;
        const v4u v = *(const GAS v4u*)(GT + ((size_t)(cb * 64 + cl) * NSEQ + b) * SEQL + tb * 64 + 8 * tc);
        __syncthreads();
        tl_[(8 * tc + 0) * 72 + cl] = (bf16)(v.x & 0xffffu); tl_[(8 * tc + 1) * 72 + cl] = (bf16)(v.x >> 16);
        tl_[(8 * tc + 2) * 72 + cl] = (bf16)(v.y & 0xffffu); tl_[(8 * tc + 3) * 72 + cl] = (bf16)(v.y >> 16);
        tl_[(8 * tc + 4) * 72 + cl] = (bf16)(v.z & 0xffffu); tl_[(8 * tc + 5) * 72 + cl] = (bf16)(v.z >> 16);
        tl_[(8 * tc + 6) * 72 + cl] = (bf16)(v.w & 0xffffu); tl_[(8 * tc + 7) * 72 + cl] = (bf16)(v.w >> 16);
        __syncthreads();
        const int tl = F.tid >> 3, cc = F.tid & 7;
        *(GAS v4u*)(O + ((size_t)b * SEQL + tb * 64 + tl) * ldo + cb * 64 + 8 * cc) = *(const LAS v4u*)(tl_ + tl * 72 + 8 * cc);
    }
}
typedef short s16x4_t __attribute__((ext_vector_type(4)));
template <int NCH> __device__ __forceinline__ unsigned img_off(unsigned row, unsigned ch) { return (128u * NCH) * (row >> 3) + 512u * (ch >> 2) + 64u * (row & 7) + 16u * ((ch & 3) ^ ((row >> 2) & 3)); }
__device__ __forceinline__ s16x4_t ds_tr(const LAS unsigned char* p) { return __builtin_bit_cast(s16x4_t, __builtin_amdgcn_ds_read_tr16_b64_v4i16((LAS s16x4_t*)p)); }
__device__ __forceinline__ float sumsq8(v4u v) {
    const float a0 = bflo(v.x), a1 = bfhi(v.x), a2 = bflo(v.y), a3 = bfhi(v.y), a4 = bflo(v.z), a5 = bfhi(v.z), a6 = bflo(v.w), a7 = bfhi(v.w);
    return ((a0 * a0 + a1 * a1) + (a2 * a2 + a3 * a3)) + ((a4 * a4 + a5 * a5) + (a6 * a6 + a7 * a7));
}
constexpr int AT_RING = 0, AT_RKT = 9 * 16384, AT_RPB = AT_RKT + 2 * 2304, AT_GN = AT_RPB + 2 * 1920;
static_assert(AT_GN + 512 <= MISC_OFF, "attention LDS map");
#define AT_WAIT(n) asm volatile("s_waitcnt vmcnt(" #n ")" ::: "memory")
#define AT_BAR() do { asm volatile("s_waitcnt lgkmcnt(0)" ::: "memory"); __builtin_amdgcn_s_barrier(); asm volatile("" ::: "memory"); } while (0)
struct AtUnit { int b, h, r0, rs0; };
__device__ __forceinline__ AtUnit at_unit(int wu) { AtUnit u; u.b = wu >> 8; u.h = (wu >> 5) & 7; u.r0 = 2 * (wu & 31); u.rs0 = min(max(u.r0 - 4, 0), 56); return u; }
__device__ __forceinline__ void attn_coop(Frame& F, gcb PAv, gb O0v, int ldo, gcf qgv, gcf kgv, gcf rpbv, gcf RKPv) {
    const int w = F.wave;
    gcb PA_ = unif_ptr(PAv); gb O0_ = unif_ptr(O0v); gcf qg_ = unif_ptr(qgv), kg_ = unif_ptr(kgv), rpb_ = unif_ptr(rpbv), RKP_ = unif_ptr(RKPv);
    asm volatile("" : "+s"(PA_), "+s"(O0_), "+s"(qg_), "+s"(kg_), "+s"(rpb_), "+s"(RKP_));
    const int per = (NSEQ * HA * 32 + F.G - 1) / F.G, NUN = NSEQ * HA * 32;
#define AT_WU(k) ((F.G == 256) ? (F.vcu >> 5) * (32 * per) + 32 * (k) + (F.vcu & 31) : F.vcu * per + (k))
#define AT_OFFS(ln_) unsigned offK[2], offV[2]; \
    _Pragma("unroll") for (int i = 0; i < 2; ++i) { const int q = 2 * w + i; \
        const int rho = 4 * q + ((ln_) >> 4), ch = ((ln_) & 15) ^ (rho & 15); \
        const int rg = q >> 1, c4 = 2 * (q & 1) + ((ln_) >> 5), r7 = ((ln_) & 31) >> 2, row = 8 * rg + r7, chv = 4 * c4 + (((ln_) & 3) ^ ((row >> 2) & 3)); \
        offK[i] = (unsigned)(rho * DHALF + DA + 8 * ch); offV[i] = (unsigned)(row * DHALF + 2 * DA + 8 * chv); }
#define AT_BASE(U) (PA + ((size_t)(U).b * SEQL + (U).rs0 * 64) * DHALF + (U).h * DH)
#define AT_ISSUE(base, off, rs0_, j) do { const int jj_ = min((j), 63 - (rs0_)); _Pragma("unroll") for (int i = 0; i < 2; ++i) \
            __builtin_amdgcn_global_load_lds((const GAS unsigned*)((base) + (size_t)jj_ * 64 * DHALF + off[i]), (LAS unsigned*)(F.lds + AT_RING + (j) * 16384 + 1024 * (2 * w + i)), 16, 0, 0); } while (0)
    if (AT_WU(0) >= NUN) return;
    { gcb PA = PA_; const AtUnit u0 = at_unit(AT_WU(0)); gcb b0 = AT_BASE(u0); const int l0_ = pg8::lane_id_asm(); AT_OFFS(l0_); (void)offV;
      __syncthreads();
      if (F.tid < DH) ((LAS float*)(F.lds + AT_GN))[F.tid] = qg_[F.tid] * kg_[F.tid];
      __syncthreads();
#pragma unroll
      for (int j = 0; j < 9; ++j) AT_ISSUE(b0, offK, u0.rs0, j); }
    for (int k = 0; k < per; ++k) {
        const int wu = AT_WU(k);
        if (wu >= NUN) break;
        const bool has_next = (k + 1 < per) && (AT_WU(k + 1) < NUN);
        const int lane = pg8::lane_id_asm();
        gcb PA = PA_; gb O_ = O0_; gcf qg = qg_, kg = kg_, rpb = rpb_, RKP = RKP_;
        asm volatile("" : "+s"(PA), "+s"(O_), "+s"(qg), "+s"(kg), "+s"(rpb), "+s"(RKP));
        const int m = lane & 15, g = lane >> 4, lq = m >> 2, lp = lane & 3;
        AT_OFFS(lane);
        const AtUnit U = at_unit(wu);
        const int b = U.b, h = U.h, r0 = U.r0, rs0 = U.rs0, r = r0 + (w >> 2), c0 = 16 * (w & 3);
        const int rs = min(max(r - 4, 0), 56), kc0 = min(max(c0 - 8, 0), 32), ro = rs - rs0;
        const size_t tokb = (size_t)b * SEQL;
        gcb baseU = AT_BASE(U);
        LAS float* rkt = (LAS float*)(F.lds + AT_RKT) + (k & 1) * 576;
        for (int e = 64 * w + lane; e < 576; e += NTHR) { const int krow = min(rs0 + (e >> 6), 63);
            const f32x4 p4 = *(const GAS f32x4*)(RKP + (tokb + krow * 64 + (e & 63)) * 32 + h * 4);
            rkt[e] = rsqrtf(((p4.x + p4.y) + (p4.z + p4.w)) * (1.f / DH) + EPS); }
        const LAS float* rkw = rkt + ro * 64 + kc0 + 4 * g;
        LAS float* rpt = (LAS float*)(F.lds + AT_RPB) + (k & 1) * 480;
        { const int e = 64 * w + lane; if (e < 465) rpt[e] = rpb[h * 465 + e]; }
        bf16x8_t Qf[4];
        {
            gcb qp = PA + (tokb + r * 64 + c0 + m) * DHALF + h * DH + 8 * g;
            v4u qr[4]; float ss = 0.f;
#pragma unroll
            for (int ks = 0; ks < 4; ++ks) { qr[ks] = *(const GAS v4u*)(qp + 32 * ks); ss += sumsq8(qr[ks]); }
            ss = pg8::sum_rows4(ss);
            const float rq = rsqrtf(ss * (1.f / DH) + EPS) * 0.08838834764831845f;
#pragma unroll
            for (int ks = 0; ks < 4; ++ks) {
                const f32x4 ga = *(const LAS f32x4*)(F.lds + AT_GN + 4 * (32 * ks + 8 * g)), gb_ = *(const LAS f32x4*)(F.lds + AT_GN + 4 * (32 * ks + 8 * g + 4));
                const v4u v = qr[ks]; v4u o;
                o.x = pk2(bflo(v.x) * rq * ga.x, bfhi(v.x) * rq * ga.y); o.y = pk2(bflo(v.y) * rq * ga.z, bfhi(v.y) * rq * ga.w);
                o.z = pk2(bflo(v.z) * rq * gb_.x, bfhi(v.z) * rq * gb_.y); o.w = pk2(bflo(v.w) * rq * gb_.z, bfhi(v.w) * rq * gb_.w);
                Qf[ks] = __builtin_bit_cast(bf16x8_t, o);
            }
        }
        f32x4 S[16];
#define AT_KSTEP(j, i) do { const LAS unsigned char* kb_ = F.lds + AT_RING + (j) * 16384; bf16x8_t kf_[2][4]; \
            _Pragma("unroll") for (int hf = 0; hf < 2; ++hf) { const int rho = kc0 + 16 * hf + m; \
                _Pragma("unroll") for (int ks = 0; ks < 4; ++ks) kf_[hf][ks] = *(const LAS bf16x8_t*)(kb_ + 256 * rho + 16 * ((4 * ks + g) ^ (rho & 15))); } \
            __builtin_amdgcn_sched_barrier(0);                                \
            _Pragma("unroll") for (int hf = 0; hf < 2; ++hf) { f32x4 a = pg8::zero4(); \
                _Pragma("unroll") for (int ks = 0; ks < 4; ++ks) a = __builtin_amdgcn_mfma_f32_16x16x32_bf16(kf_[hf][ks], Qf[ks], a, 0, 0, 0); \
                S[2 * (i) + hf] = a; } } while (0)
#define AT_KROW(j) do { if (ro == 0) { if ((j) < 8) AT_KSTEP(j, ((j) < 8 ? (j) : 0)); } else { if ((j) >= 1) AT_KSTEP(j, ((j) >= 1 ? (j) - 1 : 0)); } } while (0)
#define AT_KPAIR(p, n) do { AT_WAIT(n); AT_BAR(); if ((p) >= 1) { AT_ISSUE(baseU, offV, rs0, 2 * (p) - 2); AT_ISSUE(baseU, offV, rs0, 2 * (p) - 1); } \
            AT_KROW(2 * (p)); if (2 * (p) + 1 <= 8) AT_KROW((2 * (p) + 1 <= 8 ? 2 * (p) + 1 : 8)); } while (0)
        AT_KPAIR(0, 14); AT_KPAIR(1, 10); AT_KPAIR(2, 10); AT_KPAIR(3, 10); AT_KPAIR(4, 12);
#undef AT_KSTEP
#undef AT_KROW
#undef AT_KPAIR
        const int qc = c0 + m, cs = min(max(qc - 8, 0), 48);
        float mx = -3.0e38f;
#pragma unroll
        for (int half = 0; half < 8; ++half) {
            float bv[2][4];
#pragma unroll
            for (int t8 = 0; t8 < 2; ++t8) { const int T = 2 * half + t8; const int dr = rs + (T >> 1) - r + 7; const LAS float* bp = rpt + dr * 31 + 15 - qc;
#pragma unroll
                for (int rr = 0; rr < 4; ++rr) { const int kcol = kc0 + 16 * (T & 1) + 4 * g + rr; const bool ok = (kcol >= cs) && (kcol < cs + 16); bv[t8][rr] = bp[ok ? kcol : qc]; } }
#pragma unroll
            for (int t8 = 0; t8 < 2; ++t8) asm volatile("" : "+v"(bv[t8][0]), "+v"(bv[t8][1]), "+v"(bv[t8][2]), "+v"(bv[t8][3]));
#pragma unroll
            for (int t8 = 0; t8 < 2; ++t8) { const int T = 2 * half + t8;
                const f32x4 rk4 = *(const LAS f32x4*)(rkw + 64 * (T >> 1) + 16 * (T & 1));
#pragma unroll
                for (int rr = 0; rr < 4; ++rr) {
                    const int kcol = kc0 + 16 * (T & 1) + 4 * g + rr;
                    const bool ok = (kcol >= cs) && (kcol < cs + 16);
                    const float sv = ok ? S[T][rr] * rk4[rr] + bv[t8][rr] : -3.0e38f;
                    S[T][rr] = sv; mx = fmaxf(mx, sv);
                } }
        }
        mx = pg8::max_rows4(mx);
        float sum = 0.f;
#pragma unroll
        for (int T = 0; T < 16; ++T)
#pragma unroll
            for (int rr = 0; rr < 4; ++rr) { const float p = (S[T][rr] > -1.0e38f) ? __expf(S[T][rr] - mx) : 0.f; S[T][rr] = p; sum += p; }
        sum = pg8::sum_rows4(sum);
        const float inv = 1.f / sum;
        bf16x8_t Pf[8];
#pragma unroll
        for (int i = 0; i < 8; ++i) { v4u o; o.x = pk2(S[2 * i][0], S[2 * i][1]); o.y = pk2(S[2 * i][2], S[2 * i][3]); o.z = pk2(S[2 * i + 1][0], S[2 * i + 1][1]); o.w = pk2(S[2 * i + 1][2], S[2 * i + 1][3]);
            Pf[i] = __builtin_bit_cast(bf16x8_t, o); }
        const unsigned ldsb = (unsigned)(uintptr_t)F.lds, vE = img_off<16>(kc0 + 4 * g + lq, (lp >> 1)) + 8 * (lp & 1), vO = vE ^ 32u;
        AtUnit Un = U; if (has_next) Un = at_unit(AT_WU(k + 1));
        gcb baseN = AT_BASE(Un);
        f32x4 O[8];
#pragma unroll
        for (int dt = 0; dt < 8; ++dt) O[dt] = pg8::zero4();
#define AT_TR(dst, addr, off) asm volatile("ds_read_b64_tr_b16 %0, %1 offset:%2" : "=v"(dst) : "v"(addr), "n"(off))
#define AT_VSTEP(j, i) do { const unsigned aE_ = ldsb + vE + (unsigned)(AT_RING + (j) * 16384), aO_ = ldsb + vO + (unsigned)(AT_RING + (j) * 16384); s16x4_t tq_[16]; \
            AT_TR(tq_[0], aE_, 0); AT_TR(tq_[1], aE_, 4096); AT_TR(tq_[2], aO_, 0); AT_TR(tq_[3], aO_, 4096); \
            AT_TR(tq_[4], aE_, 512); AT_TR(tq_[5], aE_, 4608); AT_TR(tq_[6], aO_, 512); AT_TR(tq_[7], aO_, 4608); \
            AT_TR(tq_[8], aE_, 1024); AT_TR(tq_[9], aE_, 5120); AT_TR(tq_[10], aO_, 1024); AT_TR(tq_[11], aO_, 5120); \
            AT_TR(tq_[12], aE_, 1536); AT_TR(tq_[13], aE_, 5632); AT_TR(tq_[14], aO_, 1536); AT_TR(tq_[15], aO_, 5632); \
            asm volatile("s_waitcnt lgkmcnt(0)" : "+v"(tq_[0]), "+v"(tq_[1]), "+v"(tq_[2]), "+v"(tq_[3]), "+v"(tq_[4]), "+v"(tq_[5]), "+v"(tq_[6]), "+v"(tq_[7]), \
                         "+v"(tq_[8]), "+v"(tq_[9]), "+v"(tq_[10]), "+v"(tq_[11]), "+v"(tq_[12]), "+v"(tq_[13]), "+v"(tq_[14]), "+v"(tq_[15])); \
            _Pragma("unroll") for (int dt = 0; dt < 8; ++dt) { \
                const bf16x8_t Vf = __builtin_shufflevector(tq_[2 * dt], tq_[2 * dt + 1], 0, 1, 2, 3, 4, 5, 6, 7); \
                O[dt] = __builtin_amdgcn_mfma_f32_16x16x32_bf16(Vf, Pf[i], O[dt], 0, 0, 0); } } while (0)
#define AT_VCOMP(j) do { if (ro == 0) { if ((j) < 8) AT_VSTEP(j, ((j) < 8 ? (j) : 0)); } else { if ((j) >= 1) AT_VSTEP(j, ((j) >= 1 ? (j) - 1 : 0)); } } while (0)
        if (has_next) {
#define AT_VPAIR(p, n) do { AT_WAIT(n); AT_BAR(); if ((p) == 0) AT_ISSUE(baseU, offV, rs0, 8); else { AT_ISSUE(baseN, offK, Un.rs0, 2 * (p) - 2); AT_ISSUE(baseN, offK, Un.rs0, 2 * (p) - 1); } \
                AT_VCOMP(2 * (p)); if (2 * (p) + 1 <= 8) AT_VCOMP((2 * (p) + 1 <= 8 ? 2 * (p) + 1 : 8)); } while (0)
            AT_VPAIR(0, 12); AT_VPAIR(1, 10); AT_VPAIR(2, 10); AT_VPAIR(3, 10); AT_VPAIR(4, 12);
#undef AT_VPAIR
        } else {
#define AT_VPAIR(p, n) do { AT_WAIT(n); AT_BAR(); if ((p) == 0) AT_ISSUE(baseU, offV, rs0, 8); \
                AT_VCOMP(2 * (p)); if (2 * (p) + 1 <= 8) AT_VCOMP((2 * (p) + 1 <= 8 ? 2 * (p) + 1 : 8)); } while (0)
            AT_VPAIR(0, 12); AT_VPAIR(1, 10); AT_VPAIR(2, 6); AT_VPAIR(3, 2); AT_VPAIR(4, 0);
#undef AT_VPAIR
        }
#undef AT_VSTEP
#undef AT_TR
#undef AT_VCOMP
        gb op = O_ + (tokb + r * 64 + c0 + m) * ldo + h * DH + 4 * g;
#pragma unroll
        for (int dt = 0; dt < 8; ++dt) { const f32x4 o = O[dt] * inv; *(GAS v2u*)(op + 16 * dt) = (v2u){pk2(o.x, o.y), pk2(o.z, o.w)}; }
        if (has_next) {
            AT_BAR();
            AT_ISSUE(baseN, offK, Un.rs0, 8);
        }
    }
#undef AT_ISSUE
#undef AT_OFFS
#undef AT_BASE
#undef AT_WU
}
#undef AT_WAIT
#undef AT_BAR
constexpr int GM_W_OFF = 65536, GM_WRS = 288;
struct GateRegs { v4u v[8]; f32x4 p0, p1; };
__device__ __forceinline__ void gate_load(GateRegs& R, gcb ZZ, gcf RVS, int unit, int tid) {
    const int n = unit >> 3, gch = unit & 7, tok0 = n * 128;
#pragma unroll
    for (int x = 0; x < 8; ++x) { const int e = tid + NTHR * x, row = e >> 5, ch = e & 31; R.v[x] = *(const GAS v4u*)(ZZ + (size_t)(tok0 + row) * DC2 + DM + gch * 256 + 8 * ch); }
    gcf pp = RVS + (size_t)(tok0 + (tid >> 2)) * 32 + 8 * (tid & 3);
    R.p0 = *(const GAS f32x4*)pp; R.p1 = *(const GAS f32x4*)(pp + 4);
}
__device__ __forceinline__ void gate_rv(const GateRegs& R, LAS float* rvl, int tid) {
    float sacc = ((R.p0[0] + R.p0[1]) + (R.p0[2] + R.p0[3])) + ((R.p1[0] + R.p1[1]) + (R.p1[2] + R.p1[3]));
    sacc += swz_xor<1>(sacc); sacc += swz_xor<2>(sacc);
    if ((tid & 3) == 0) rvl[tid >> 2] = rsqrtf(sacc * (1.f / DM) + EPS);
}
__device__ __forceinline__ unsigned scale2(unsigned w, float r) { return pk2(bflo(w) * r, bfhi(w) * r); }
__device__ __forceinline__ void gmlp_gate_mfma(Frame& F, gb ZZ, gcf vgain, gcf ws_, gcf bs_) {
    const int w = F.wave;
    LAS float* rvl = (LAS float*)(F.lds + GM_W_OFF + 128 * GM_WRS);
    const int NU = (M / 128) * 8;
    if ((F.G & 7) != 0) return;
    const int gch = F.bx & 7;
    int unit = F.bx;
    GateRegs R;
    if (unit < NU) gate_load(R, ZZ, F.RVS, unit, F.tid);
    __syncthreads();
    for (int e = F.tid; e < 128 * 16; e += NTHR) { const int p = e >> 4, q8 = e & 15; gcf wp = ws_ + (size_t)gch * 16384 + p * 128 + 8 * q8;
        const f32x4 a = *(const GAS f32x4*)wp, bq = *(const GAS f32x4*)(wp + 4);
        *(LAS v4u*)(F.lds + GM_W_OFF + p * GM_WRS + 16 * q8) = (v4u){pk2(a.x, a.y), pk2(a.z, a.w), pk2(bq.x, bq.y), pk2(bq.z, bq.w)}; }
    if (unit < NU) gate_rv(R, rvl, F.tid);
    int par = 0;
    for (; unit < NU; unit += F.G, par ^= 1) {
        const int tok0 = (unit >> 3) * 128;
        int lane_ = F.lane; asm volatile("" : "+v"(lane_));
        const int m = lane_ & 15, g4 = lane_ >> 4, lq = m >> 2, lp = lane_ & 3;
        __syncthreads();
#pragma unroll
        for (int x = 0; x < 8; ++x) { const int e = F.tid + NTHR * x; const float r = rvl[par * 128 + (e >> 5)]; const v4u v = R.v[x];
            *(LAS v4u*)(F.lds + img_off<32>(e >> 5, e & 31)) = (v4u){scale2(v.x, r), scale2(v.y, r), scale2(v.z, r), scale2(v.w, r)}; }
        if (unit + F.G < NU) gate_load(R, ZZ, F.RVS, unit + F.G, F.tid);
        __syncthreads();
        f32x4 acc[8][2];
#pragma unroll
        for (int mt = 0; mt < 8; ++mt) { acc[mt][0] = pg8::zero4(); acc[mt][1] = pg8::zero4(); }
#pragma unroll
        for (int ks = 0; ks < 4; ++ks) {
            bf16x8_t Vf[2];
#pragma unroll
            for (int jj = 0; jj < 2; ++jj) { const int ct = 2 * w + jj;
                const s16x4_t t0 = ds_tr(F.lds + img_off<32>(32 * ks + 8 * g4 + lq, 2 * ct + (lp >> 1)) + 8 * (lp & 1));
                const s16x4_t t1 = ds_tr(F.lds + img_off<32>(32 * ks + 8 * g4 + 4 + lq, 2 * ct + (lp >> 1)) + 8 * (lp & 1));
                Vf[jj] = __builtin_shufflevector(t0, t1, 0, 1, 2, 3, 4, 5, 6, 7); }
#pragma unroll
            for (int mt = 0; mt < 8; ++mt) { const bf16x8_t Wf = *(const LAS bf16x8_t*)(F.lds + GM_W_OFF + (16 * mt + m) * GM_WRS + 64 * ks + 16 * g4);
                acc[mt][0] = __builtin_amdgcn_mfma_f32_16x16x32_bf16(Vf[0], Wf, acc[mt][0], 0, 0, 0);
                acc[mt][1] = __builtin_amdgcn_mfma_f32_16x16x32_bf16(Vf[1], Wf, acc[mt][1], 0, 0, 0); }
        }
        if (unit + F.G < NU) gate_rv(R, rvl + (par ^ 1) * 128, F.tid);
        const int colb = gch * 256 + 32 * w + 4 * g4;
        const f32x4 gn0 = *(const GAS f32x4*)(vgain + colb), gn1 = *(const GAS f32x4*)(vgain + colb + 16);
        gb ub = ZZ + (size_t)(tok0 + m) * DC2 + colb;
        float bsq[8]; v2u uq[8][2];
#pragma unroll
        for (int mt = 0; mt < 8; ++mt) { bsq[mt] = bs_[gch * 128 + 16 * mt + m];
#pragma unroll
            for (int jj = 0; jj < 2; ++jj) uq[mt][jj] = *(const GAS v2u*)(ub + (size_t)(16 * mt) * DC2 + 16 * jj); }
#pragma unroll
        for (int mt = 0; mt < 8; ++mt) { asm volatile("" : "+v"(bsq[mt]));
#pragma unroll
            for (int jj = 0; jj < 2; ++jj) asm volatile("" : "+v"(uq[mt][jj])); }
#pragma unroll
        for (int mt = 0; mt < 8; ++mt) { const float bsp = bsq[mt];
#pragma unroll
            for (int jj = 0; jj < 2; ++jj) { const f32x4 gn = jj ? gn1 : gn0; const f32x4 sv = acc[mt][jj] * gn + bsp;
                const v2u uu = uq[mt][jj];
                *(GAS v2u*)(ub + (size_t)(16 * mt) * DC2 + 16 * jj) = (v2u){pk2(bflo(uu.x) * sv.x, bfhi(uu.x) * sv.y), pk2(bflo(uu.y) * sv.z, bfhi(uu.y) * sv.w)}; } }
    }
}

__device__ __forceinline__ void make_frame(Frame& F, const Params*& kp, int wbase) {
    const Params* k = (const Params*)__builtin_amdgcn_kernarg_segment_ptr();
    asm volatile("" : "+s"(k));
    kp = k;
    const int t_ = wbase + pg8::lane_id_asm();
    extern __shared__ __attribute__((aligned(16))) unsigned char lds_raw[];
    F.lds = (LAS unsigned char*)lds_raw;
    F.MISC = (volatile LAS unsigned*)(F.lds + MISC_OFF);
    F.tid = t_; F.lane = t_ & 63; { int wv = wbase >> 6; asm volatile("" : "+s"(wv)); F.wave = wv; } F.wbase = wbase;
    F.G = gridDim.x; { int bx = blockIdx.x; asm volatile("" : "+s"(bx)); F.bx = bx; F.vcu = (F.G % 8 == 0) ? (bx % 8) * (F.G / 8) + bx / 8 : bx; }
    GAS unsigned char* ws = (GAS unsigned char*)k->ws; F.ws = ws;
    F.ctl = (gu32*)(ws + WS_CTL);
    F.xp = (gcf)k->in[0]; F.xs = (gcf)k->in[1]; F.out = (gf)k->out;
    F.W1 = (gb)(ws + WS_W1); F.W2 = (gb)(ws + WS_W2); F.XB = (gb)(ws + WS_XB);
    F.FILT = (gf)(ws + WS_FILT); F.SSA = (gb)(ws + WS_SSA); F.SSB = (gb)(ws + WS_SSB); F.RVS = (gf)(ws + WS_RVS); F.INVS = (gf)(ws + WS_INVS); F.RVF = (gb)(ws + WS_RVF);
}
__device__ __forceinline__ void grid_bar() {
    const Params* k = (const Params*)__builtin_amdgcn_kernarg_segment_ptr();
    asm volatile("" : "+s"(k));
    extern __shared__ __attribute__((aligned(16))) unsigned char lds_raw[];
    XcdBarrier b; b.bar = (unsigned*)(k->ws + WS_CTL) + CW_BAR; b.x = xb_xcc_id(); b.st = (volatile LAS unsigned*)((LAS unsigned char*)lds_raw + MISC_OFF) + 8;
    xcd_barrier(b);
}
constexpr int NPHASES = 25;
__global__ void __launch_bounds__(NTHR, 2) fwd_kernel(Params P) {
    extern __shared__ __attribute__((aligned(16))) unsigned char lds_raw[];
    {
        volatile LAS unsigned* MISC = (volatile LAS unsigned*)((LAS unsigned char*)lds_raw + MISC_OFF);
        if (threadIdx.x < 32) MISC[threadIdx.x] = 0u;
        __syncthreads();
    }
    const int lo = P.ph_lo, hi = P.ph_hi;
    const int wbase = __builtin_amdgcn_readfirstlane(threadIdx.x);
    if (hi - lo > 1) (void)xcd_barrier_post((unsigned*)(P.ws + WS_CTL) + CW_BAR, (volatile LAS unsigned*)((LAS unsigned char*)lds_raw + MISC_OFF) + 8);
    int ph = 0;
#define PH_BEGIN if (ph >= lo && ph < hi) { Frame F; const Params* kp; make_frame(F, kp, wbase); \
    const gb BIG = (gb)(F.ws + WS_BIG); const gb PA = (gb)(F.ws + WS_BIG + BIG_PA); const gb PB = (gb)(F.ws + WS_BIG + BIG_PB); \
    const gb UT = (gb)(F.ws + WS_BIG + BIG_UT); const gb X0T = (gb)(F.ws + WS_BIG + BIG_X0T); const gb GT = PB; \
    const gb WINc = (gb)(F.ws + ((layer & 1) ? WS_WIN2 : WS_WIN)); const gb WOUTc = (gb)(F.ws + ((layer & 1) ? WS_WOUT2 : WS_WOUT)); \
    (void)BIG; (void)PA; (void)PB; (void)UT; (void)X0T; (void)GT; (void)WINc; (void)WOUTc;
#define PH_END if (ph + 1 < hi) grid_bar(); } ++ph;
#define LAYER_CHORES() do { \
        gcf nmix = ((gcf)kp->in[2]) + (layer + 1) * DM; gcf nmlp = ((gcf)kp->in[3]) + layer * DM; \
        gcf w1f = ((gcf)kp->in[25]) + (size_t)layer * DM * DFF; gcf w2f = ((gcf)kp->in[26]) + (size_t)layer * DFF * DM; \
        if (layer == 0) { const CvtJob jobs[2] = { {((gcf)kp->in[20]), nmix, (gb)(F.ws + WS_WIN2), DM, DC2}, {((gcf)kp->in[24]), nullptr, (gb)(F.ws + WS_WOUT2), DM, DM} }; convert_jobs<2>(F, jobs, 0); } \
        else if (layer == 1) { const CvtJob jobs[4] = { {((gcf)kp->in[4]) + (size_t)DM * DINAB, nmix, (gb)(F.ws + WS_WIN), DM, DINAB}, {((gcf)kp->in[19]) + (size_t)DM * DM, nullptr, (gb)(F.ws + WS_WOUT), DM, DM}, \
                                                         {w1f, nmlp, F.W1, DM, DFF}, {w2f, nullptr, F.W2, DFF, DM} }; convert_jobs<4>(F, jobs, 0); } \
        else if (layer == 2) { const CvtJob jobs[4] = { {((gcf)kp->in[20]) + (size_t)DM * DC2, nmix, (gb)(F.ws + WS_WIN2), DM, DC2}, {((gcf)kp->in[24]) + (size_t)DM * DM, nullptr, (gb)(F.ws + WS_WOUT2), DM, DM}, \
                                                         {w1f, nmlp, F.W1, DM, DFF}, {w2f, nullptr, F.W2, DFF, DM} }; convert_jobs<4>(F, jobs, 0); } \
        else { const CvtJob jobs[2] = { {w1f, nmlp, F.W1, DM, DFF}, {w2f, nullptr, F.W2, DFF, DM} }; convert_jobs<2>(F, jobs, 0); } \
    } while (0)

    {
        const int layer = 0;
        PH_BEGIN
              xb_rows(F);
            const CvtJob jobs[4] = { {((gcf)kp->in[4]), ((gcf)kp->in[2]), WINc, DM, DINAB}, {((gcf)kp->in[19]), nullptr, WOUTc, DM, DM}, {((gcf)kp->in[25]), ((gcf)kp->in[3]), F.W1, DM, DFF}, {((gcf)kp->in[26]), nullptr, F.W2, DFF, DM} };
              convert_jobs<4>(F, jobs, 0);
            filter_gen(F, ((gcf)kp->in[10]), ((gcf)kp->in[11]), ((gcf)kp->in[12]), ((gcf)kp->in[13]), ((gcf)kp->in[14]), ((gcf)kp->in[15]), ((gcf)kp->in[16]), ((gcf)kp->in[17]));
        PH_END
    }
    for (int layer = 0; layer < 4; ++layer) {
        const int j = layer >> 1;
        if ((layer & 1) == 0) {
            PH_BEGIN
                pg8::Gemm g{(const bf16*)F.XB, (const bf16*)WINc, M, DINAB, DM, DM, F.wbase}; pg8::StaticOrder S; S.init(M, DINAB, F.G, F.bx);
                pg8::EpiBf16<0, false, true> E{PA, DHALF, DHALF, (size_t)(PB - PA), F.SSA, F.RVS, 0, F.lds + RING_BYTES};
                pg8::gemm_phase<pg8::EpiBf16<0, false, true>, pg8::StaticOrder, true, true>(F.lds, g, S, E);
            PH_END
            PH_BEGIN
                  hyena_prep(F, PB, UT, X0T, ((gcf)kp->in[5]) + j * 3 * DHALF, ((gcf)kp->in[6]) + j * DHALF);
                filter_norm(F);
                __syncthreads();
                  LAYER_CHORES();
                __syncthreads();
                make_frame(F, kp, wbase);
                  attn_coop(F, (gcb)(F.ws + WS_BIG + BIG_PA), (gb)(F.ws + WS_BIG + BIG_PA), DHALF, ((gcf)kp->in[7]) + j * DH, ((gcf)kp->in[8]) + j * DH, ((gcf)kp->in[9]) + j * HA * 15 * 31, F.RVS);
            PH_END
            PH_BEGIN
                hyena_conv_mfma(F, UT, X0T, GT, ((gcf)kp->in[18]) + j * DB);
            PH_END
            PH_BEGIN
                hyena_post(F, GT, PA + DA, DHALF);
            PH_END
            PH_BEGIN
                pg8::Gemm g{(const bf16*)PA, (const bf16*)WOUTc, M, DM, DM, DHALF, F.wbase}; pg8::StaticOrder S; S.init(M, DM, F.G, F.bx);
                { pg8::EpiRes<1> E{nullptr, nullptr, 0, F.out, DM, F.XB, F.SSB};
                    pg8::gemm_phase<pg8::EpiRes<1>, pg8::StaticOrder, true, true>(F.lds, g, S, E); }
            PH_END
        } else {
            PH_BEGIN
                pg8::Gemm g{(const bf16*)F.XB, (const bf16*)WINc, M, DC2, DM, DM, F.wbase}; pg8::StaticOrder S; S.init(M, DC2, F.G, F.bx);
                pg8::EpiBf16<1, true> E{BIG, DC2, 0, 0, F.SSA, F.RVS, 8, F.lds + RING_BYTES};
                pg8::gemm_phase<pg8::EpiBf16<1, true>, pg8::StaticOrder, true, true>(F.lds, g, S, E);
            PH_END
            PH_BEGIN
                  gmlp_gate_mfma(F, BIG, ((gcf)kp->in[21]) + j * DM, ((gcf)kp->in[22]) + (size_t)j * 8 * 128 * 128, ((gcf)kp->in[23]) + j * 8 * 128);
                __syncthreads();
                  LAYER_CHORES();
                  if (layer == 1) filter_gen(F, ((gcf)kp->in[10]) + EMB * FO, ((gcf)kp->in[11]) + FO, ((gcf)kp->in[12]) + FO * FO, ((gcf)kp->in[13]) + FO, ((gcf)kp->in[14]) + FO * FO, ((gcf)kp->in[15]) + FO, ((gcf)kp->in[16]) + (size_t)FO * 2 * DB, ((gcf)kp->in[17]) + FO);
            PH_END
            PH_BEGIN
                pg8::Gemm g{(const bf16*)BIG, (const bf16*)WOUTc, M, DM, DM, DC2, F.wbase}; pg8::StaticOrder S; S.init(M, DM, F.G, F.bx);
                pg8::EpiRes<1> E{nullptr, nullptr, 0, F.out, DM, F.XB, F.SSB};
                pg8::gemm_phase<pg8::EpiRes<1>, pg8::StaticOrder, true, true>(F.lds, g, S, E);
            PH_END
        }
        PH_BEGIN
            pg8::Gemm g{(const bf16*)F.XB, (const bf16*)F.W1, M, DFF, DM, DM, F.wbase}; pg8::StaticOrder S; S.init(M, DFF, F.G, F.bx);
            pg8::EpiBf16<2, false> E{BIG, DFF, 0, 0, F.SSB, nullptr, 0, F.lds + RING_BYTES};
            pg8::gemm_phase<pg8::EpiBf16<2, false>, pg8::StaticOrder, true, true>(F.lds, g, S, E);
        PH_END
        PH_BEGIN
            pg8::Gemm g{(const bf16*)BIG, (const bf16*)F.W2, M, DM, DFF, DFF, F.wbase}; pg8::StaticOrder S; S.init(M, DM, F.G, F.bx);
            if (layer < 3) { pg8::EpiRes<1> E{nullptr, nullptr, 0, F.out, DM, F.XB, F.SSA};
                pg8::gemm_phase<pg8::EpiRes<1>, pg8::StaticOrder, true, true>(F.lds, g, S, E); }
            else { pg8::EpiRes<2> E{nullptr, nullptr, 0, F.out, DM, F.XB, F.SSA};
                pg8::gemm_phase<pg8::EpiRes<2>, pg8::StaticOrder, true, true>(F.lds, g, S, E); }
        PH_END
    }
#undef PH_BEGIN
#undef PH_END
#undef LAYER_CHORES
}

#ifndef MK_ONE_LAUNCH
#define MK_ONE_LAUNCH 1
#endif
extern "C" void kernel_launch(void* const* d_in, const int* in_sizes, int n_in, void* d_out, int out_size, void* d_ws, size_t ws_size, hipStream_t stream) {
    static int grid = 0;
    if (grid == 0) {
        if (n_in != 27 || out_size != M * DM || ws_size < WS_END) { fprintf(stderr, "kernel_launch: unexpected shapes (n_in %d out %d ws %zu)\n", n_in, out_size, ws_size); grid = -1; return; }
        int dev = 0, cus = 0;
        if (hipGetDevice(&dev) != hipSuccess || hipDeviceGetAttribute(&cus, hipDeviceAttributeMultiprocessorCount, dev) != hipSuccess) { grid = -1; return; }
        if (hipFuncSetAttribute((const void*)fwd_kernel, hipFuncAttributeMaxDynamicSharedMemorySize, LDS_BYTES) != hipSuccess) { fprintf(stderr, "kernel_launch: hipFuncSetAttribute failed\n"); grid = -1; return; }
        (void)hipGetLastError();
        grid = cus;
    }
    if (grid < 0) return;
    (void)hipMemsetAsync((char*)d_ws + WS_CTL, 0, CTL_ZERO_BYTES, stream);
    Params p{};
    for (int i = 0; i < 27; ++i) p.in[i] = (const float*)d_in[i];
    p.out = (float*)d_out; p.ws = (unsigned char*)d_ws;
#if MK_ONE_LAUNCH
    p.ph_lo = 0; p.ph_hi = NPHASES;
    hipLaunchKernelGGL(fwd_kernel, dim3(grid), dim3(NTHR), LDS_BYTES, stream, p);
#else
    for (int ph = 0; ph < NPHASES; ++ph) { p.ph_lo = ph; p.ph_hi = ph + 1; hipLaunchKernelGGL(fwd_kernel, dim3(grid), dim3(NTHR), LDS_BYTES, stream, p); }
#endif
}
```

```cpp
#include <hip/hip_runtime.h>
#include <cstdio>
#include <cstdint>
#include <cmath>
namespace pg8 {
#define PG8_LAS __attribute__((address_space(3)))
typedef unsigned short bf16_t;
typedef short bf16x8 __attribute__((ext_vector_type(8)));
typedef float f32x4 __attribute__((ext_vector_type(4)));
typedef unsigned u32x4 __attribute__((ext_vector_type(4)));
constexpr int BM = 256, BK = 64, HALF = 128, HTB = HALF * BK * 2  , STAGE_BYTES = 8 * HTB, NXCD = 8, WGM = 8;

__host__ __device__ __forceinline__ int lds_byte(int r, int c) { const int st = (r >> 4) * 2 + (c >> 5), rr = r & 15, cc = c & 31, ob = rr * 64 + cc * 2; return st * 1024 + (ob ^ (((ob >> 9) & 1) << 5)); }
__host__ __device__ __forceinline__ void stage_rc(int b, int& R, int& C) { const int st = b / 1024, sb = b % 1024, swz = sb ^ (((sb >> 9) & 1) << 5); R = (st >> 1) * 16 + swz / 64; C = (st & 1) * 32 + (swz % 64) / 2; }
__host__ __device__ __forceinline__ int perm32(int rho) { const int n = rho >> 4, i = rho & 15; return 8 * (i >> 2) + 4 * n + (i & 3); }

struct Unit { int pm, pn; };
struct Gemm { const bf16_t* A; const bf16_t* Bt; int M, N, K, lda, wbase; };
__device__ __forceinline__ int lane_id_asm() { int l; asm volatile("v_mbcnt_lo_u32_b32 %0, -1, 0\n\tv_mbcnt_hi_u32_b32 %0, -1, %0" : "=v"(l)); return l; }

struct StaticOrder {
    int nM, nN, nwg, G, c;
    __host__ __device__ void init(int M, int N, int G_, int c_) { nM = M / BM; nN = N / BM; nwg = nM * nN; G = G_; c = c_; }
    __host__ __device__ bool next(int i, Unit& u) const {
        const long L = (long)i * G + c; if (L >= nwg) return false;
        int wgid = (int)L; { const int q = nwg / NXCD, r = nwg % NXCD, xcd = wgid % NXCD, off = wgid / NXCD; wgid = (xcd < r ? xcd * (q + 1) : r * (q + 1) + (xcd - r) * q) + off; }
        const int nig = WGM * nN, gid = wgid / nig, fm = gid * WGM, gsz = (nM - fm) < WGM ? (nM - fm) : WGM;
        u.pm = fm + ((wgid % nig) % gsz); u.pn = (wgid % nig) / gsz; return true;
    }
    __device__ __forceinline__ void a_ready(const Unit&) const {}
    __device__ __forceinline__ void done(const Unit&) const {}
};

#define PG8_GAS __attribute__((address_space(1)))
__device__ __forceinline__ unsigned cvt_pk_bf16(float lo, float hi) { unsigned r; asm volatile("v_cvt_pk_bf16_f32 %0, %1, %2" : "=v"(r) : "v"(lo), "v"(hi)); return r; }
__device__ __forceinline__ f32x4 zero4() { f32x4 z; asm volatile("v_mov_b32 %0, 0\n\tv_mov_b32 %1, 0\n\tv_mov_b32 %2, 0\n\tv_mov_b32 %3, 0" : "=v"(z[0]), "=v"(z[1]), "=v"(z[2]), "=v"(z[3])); return z; }
__device__ __forceinline__ float sum_rows4(float v) {
    unsigned u = __builtin_bit_cast(unsigned, v);
    const auto r = __builtin_amdgcn_permlane16_swap(u, u, false, false);
    const float s = __builtin_bit_cast(float, (unsigned)r[0]) + __builtin_bit_cast(float, (unsigned)r[1]);
    u = __builtin_bit_cast(unsigned, s);
    const auto q = __builtin_amdgcn_permlane32_swap(u, u, false, false);
    return __builtin_bit_cast(float, (unsigned)q[0]) + __builtin_bit_cast(float, (unsigned)q[1]);
}
__device__ __forceinline__ float max_rows4(float v) {
    unsigned u = __builtin_bit_cast(unsigned, v);
    const auto r = __builtin_amdgcn_permlane16_swap(u, u, false, false);
    const float s = fmaxf(__builtin_bit_cast(float, (unsigned)r[0]), __builtin_bit_cast(float, (unsigned)r[1]));
    u = __builtin_bit_cast(unsigned, s);
    const auto q = __builtin_amdgcn_permlane32_swap(u, u, false, false);
    return fmaxf(__builtin_bit_cast(float, (unsigned)q[0]), __builtin_bit_cast(float, (unsigned)q[1]));
}
__device__ __forceinline__ void add_f32_ret(float* p, float v) { const float old = __hip_atomic_fetch_add(p, v, __ATOMIC_RELAXED, __HIP_MEMORY_SCOPE_AGENT); asm volatile("" :: "v"(old)); }
__device__ __forceinline__ float gelu_tanh(float x) {
    const float a2 = 1.5957691216f * x * (1.0f + 0.044715f * x * x);
    const float e = __builtin_amdgcn_exp2f(-1.4426950408889634f * a2);
    return x * __builtin_amdgcn_rcpf(1.0f + e);
}
template <int ACT> __device__ __forceinline__ float act_fn(float v) {
    if (ACT == 1) return gelu_tanh(v);
    if (ACT == 2) { const float r = v > 0.f ? v : 0.f; return r * r; }
    return v;
}
template <int ACT, bool RVS, bool KN = false> struct EpiBf16 {
    static constexpr bool PERM = true, AFTER_DRAIN = false;
    PG8_GAS bf16_t* O; int ldc; int split_cols; size_t split_stride; const PG8_GAS bf16_t* ps; PG8_GAS float* rvs; int rvs_pn0; PG8_LAS unsigned char* psl;
    __device__ __forceinline__ void pre(const Unit& u, int wid, int lane) const {
#pragma unroll
        for (int i = 0; i < 2; ++i) { const int j = 2 * wid + i;
            __builtin_amdgcn_global_load_lds((const PG8_GAS unsigned*)(ps + ((size_t)(u.pm * BM + 16 * j + (lane >> 2)) * 32 + 8 * (lane & 3))), (PG8_LAS unsigned*)(psl + 1024 * j), 16, 0, 0); }
    }
    __device__ __forceinline__ void operator()(const f32x4 (&acc)[2][2][4][2], const Unit& u, int wr, int wc, int fr, int fq) const {
        const int row0 = u.pm * BM + wr * 64 + fr; int colt = u.pn * BM; PG8_GAS bf16_t* base = O;
        if (split_cols) { const int t = colt / split_cols; base += (size_t)t * split_stride; colt -= t * split_cols; }
        const int col0 = colt + wc * 32 + 8 * fq;
        float rr[2][4];
#pragma unroll
        for (int ai = 0; ai < 2; ++ai)
#pragma unroll
            for (int m = 0; m < 4; ++m) { const u32x4 pv = *(const PG8_LAS u32x4*)(psl + (wr * 64 + fr + ai * HALF + m * 16) * 64 + 16 * fq);
                const float s8 = ((__builtin_bit_cast(float, pv.x << 16) + __builtin_bit_cast(float, pv.x & 0xffff0000u)) + (__builtin_bit_cast(float, pv.y << 16) + __builtin_bit_cast(float, pv.y & 0xffff0000u)))
                               + ((__builtin_bit_cast(float, pv.z << 16) + __builtin_bit_cast(float, pv.z & 0xffff0000u)) + (__builtin_bit_cast(float, pv.w << 16) + __builtin_bit_cast(float, pv.w & 0xffff0000u)));
                rr[ai][m] = __builtin_amdgcn_rsqf(sum_rows4(s8) * (1.0f / 2048.0f) + 1e-6f); }
        const bool do_rvs = RVS && (u.pn >= rvs_pn0);
#pragma unroll
        for (int ai = 0; ai < 2; ++ai)
#pragma unroll
            for (int m = 0; m < 4; ++m) { PG8_GAS bf16_t* rowp = base + (size_t)(row0 + ai * HALF + m * 16) * ldc + col0; const float r = rr[ai][m]; float sq = 0.f; float sk[2] = {0.f, 0.f};
#pragma unroll
                for (int bj = 0; bj < 2; ++bj) { const f32x4 v0 = acc[ai][bj][m][0] * r, v1 = acc[ai][bj][m][1] * r;
                    const float a0 = act_fn<ACT>(v0[0]), a1 = act_fn<ACT>(v0[1]), a2 = act_fn<ACT>(v0[2]), a3 = act_fn<ACT>(v0[3]);
                    const float a4 = act_fn<ACT>(v1[0]), a5 = act_fn<ACT>(v1[1]), a6 = act_fn<ACT>(v1[2]), a7 = act_fn<ACT>(v1[3]);
                    if (RVS) sq += ((a0 * a0 + a1 * a1) + (a2 * a2 + a3 * a3)) + ((a4 * a4 + a5 * a5) + (a6 * a6 + a7 * a7));
                    if (KN) sk[bj] = ((a0 * a0 + a1 * a1) + (a2 * a2 + a3 * a3)) + ((a4 * a4 + a5 * a5) + (a6 * a6 + a7 * a7));
                    u32x4 w; w.x = cvt_pk_bf16(a0, a1); w.y = cvt_pk_bf16(a2, a3); w.z = cvt_pk_bf16(a4, a5); w.w = cvt_pk_bf16(a6, a7);
                    *(PG8_GAS u32x4*)(rowp + bj * HALF) = w; }
                if (RVS) { sq = sum_rows4(sq);
                    if (do_rvs && fq == 0) rvs[(size_t)(row0 + ai * HALF + m * 16) * 32 + (u.pn - rvs_pn0) * 4 + wc] = sq; }
                if (KN) { if (u.pn >= 4 && u.pn < 8) { const float s0 = sum_rows4(sk[0]), s1 = sum_rows4(sk[1]);
                    if (fq == 0) { PG8_GAS float* kp = rvs + (size_t)(row0 + ai * HALF + m * 16) * 32 + (u.pn - 4) * 8 + wc; kp[0] = s0; kp[4] = s1; } } } }
    }
};
template <int MODE> struct EpiRes {
    static constexpr bool PERM = true, AFTER_DRAIN = false;
    const PG8_GAS float* base_lo; const PG8_GAS float* base_hi; int split_row; PG8_GAS float* out; int ldc; PG8_GAS bf16_t* xb; PG8_GAS bf16_t* ps;
    __device__ __forceinline__ void pre(const Unit&, int, int) const {}
    __device__ __forceinline__ void operator()(const f32x4 (&acc)[2][2][4][2], const Unit& u, int wr, int wc, int fr, int fq) const {
        const int row0 = u.pm * BM + wr * 64 + fr, col0 = u.pn * BM + wc * 32 + 8 * fq;
        const PG8_GAS float* bp = (u.pm * BM < split_row) ? base_lo : base_hi;
        u32x4 xv[2][4][2];
        if (MODE != 0) {
#pragma unroll
            for (int ai = 0; ai < 2; ++ai)
#pragma unroll
                for (int m = 0; m < 4; ++m)
#pragma unroll
                    for (int bj = 0; bj < 2; ++bj) xv[ai][m][bj] = *(const PG8_GAS u32x4*)(xb + (size_t)(row0 + ai * HALF + m * 16) * ldc + col0 + bj * HALF);
        }
#pragma unroll
        for (int ai = 0; ai < 2; ++ai)
#pragma unroll
            for (int m = 0; m < 4; ++m) { const size_t off = (size_t)(row0 + ai * HALF + m * 16) * ldc + col0; float sq = 0.f;
#pragma unroll
                for (int bj = 0; bj < 2; ++bj) {
                    f32x4 o0, o1;
                    if (MODE == 0) { o0 = *(const PG8_GAS f32x4*)(bp + off + bj * HALF); o1 = *(const PG8_GAS f32x4*)(bp + off + bj * HALF + 4); }
                    else { const u32x4 x4 = xv[ai][m][bj];
                        o0 = (f32x4){__builtin_bit_cast(float, x4.x << 16), __builtin_bit_cast(float, x4.x & 0xffff0000u), __builtin_bit_cast(float, x4.y << 16), __builtin_bit_cast(float, x4.y & 0xffff0000u)};
                        o1 = (f32x4){__builtin_bit_cast(float, x4.z << 16), __builtin_bit_cast(float, x4.z & 0xffff0000u), __builtin_bit_cast(float, x4.w << 16), __builtin_bit_cast(float, x4.w & 0xffff0000u)}; }
                    o0 += acc[ai][bj][m][0]; o1 += acc[ai][bj][m][1];
                    if (MODE == 2) { *(PG8_GAS f32x4*)(out + off + bj * HALF) = o0; *(PG8_GAS f32x4*)(out + off + bj * HALF + 4) = o1; }
                    else { sq += ((o0[0] * o0[0] + o0[1] * o0[1]) + (o0[2] * o0[2] + o0[3] * o0[3])) + ((o1[0] * o1[0] + o1[1] * o1[1]) + (o1[2] * o1[2] + o1[3] * o1[3]));
                        u32x4 w; w.x = cvt_pk_bf16(o0[0], o0[1]); w.y = cvt_pk_bf16(o0[2], o0[3]); w.z = cvt_pk_bf16(o1[0], o1[1]); w.w = cvt_pk_bf16(o1[2], o1[3]);
                        *(PG8_GAS u32x4*)(xb + off + bj * HALF) = w; } }
                if (MODE != 2) { sq = sum_rows4(sq); if (fq == 0) ps[(size_t)(row0 + ai * HALF + m * 16) * 32 + u.pn * 4 + wc] = (bf16_t)(cvt_pk_bf16(sq, 0.f) & 0xffffu); }
                if (MODE == 0 && (m & 1)) asm volatile("" ::: "memory"); }
    }
};

template <class Epi, class Sched, bool ALIGN_EPI = false, bool SP2 = false>
__device__ __forceinline__ void gemm_phase(PG8_LAS unsigned char* lds, const Gemm g, const Sched& S, const Epi& E) {
    const int tid = g.wbase + lane_id_asm(), wid = __builtin_amdgcn_readfirstlane(tid >> 6), lane = tid & 63, wr = wid >> 2, wc = wid & 3, fr = lane & 15, fq = lane >> 4;
    const int K = g.K, nt = K / BK, LDA = g.lda;
    unsigned voffA, voffB;
    { int R, C; stage_rc(tid * 16, R, C); const int Rb = Epi::PERM ? ((R & ~31) + perm32(R & 31)) : R;
      voffA = (unsigned)(R * LDA + C) * 2u; voffB = (unsigned)(Rb * K + C) * 2u; }
    const size_t s64voffA = (size_t)64 * LDA * 2, s64voffB = (size_t)64 * K * 2;
    const size_t kstep = (size_t)(BK * 2);
    const size_t hstep = (size_t)HALF * K * 2, hstepA = (size_t)HALF * LDA * 2;
    const size_t tstep = 2 * hstep, tstepA = 2 * hstepA;
    const unsigned ldsw = (unsigned)wid * 1024u;
    const int aoff = lds_byte(wr * 64 + fr, fq * 8), boff = lds_byte(wc * 32 + fr, fq * 8);
#define PG8_SA(b, h) (((b) * 2 + (h)) * HTB)
#define PG8_SB(b, h) ((4 + (b) * 2 + (h)) * HTB)
#define PG8_STAGE(bufoff, gbase, voff) do { _Pragma("unroll") for (int _i = 0; _i < 2; ++_i) \
        __builtin_amdgcn_global_load_lds((const unsigned*)((const char*)(gbase) + _i * s64##voff + (voff)), (PG8_LAS unsigned*)(lds + (bufoff) + ldsw + _i * 8192), 16, 0, 0); } while (0)
#define PG8_LDA(dst, b, h) do { _Pragma("unroll") for (int m = 0; m < 4; ++m) _Pragma("unroll") for (int k = 0; k < 2; ++k) dst[m][k] = *(const PG8_LAS bf16x8*)(lds + PG8_SA(b, h) + aoff + m * 2048 + k * 1024); } while (0)
#define PG8_LDB(dst, b, h) do { _Pragma("unroll") for (int n = 0; n < 2; ++n) _Pragma("unroll") for (int k = 0; k < 2; ++k) dst[n][k] = *(const PG8_LAS bf16x8*)(lds + PG8_SB(b, h) + boff + n * 2048 + k * 1024); } while (0)
#define PG8_MMA(ai, bj, At, Bt) do { __builtin_amdgcn_s_setprio(1); _Pragma("unroll") for (int m = 0; m < 4; ++m) _Pragma("unroll") for (int n = 0; n < 2; ++n) _Pragma("unroll") for (int k = 0; k < 2; ++k) \
        acc[ai][bj][m][n] = __builtin_amdgcn_mfma_f32_16x16x32_bf16(Bt[n][k], At[m][k], acc[ai][bj][m][n], 0, 0, 0); __builtin_amdgcn_s_setprio(0); } while (0)
#define PG8_WAIT_V(n) asm volatile("s_waitcnt vmcnt(" #n ")" ::: "memory")
#define PG8_WAIT_L(n) asm volatile("s_waitcnt lgkmcnt(" #n ")" ::: "memory")
#define PG8_BAR __builtin_amdgcn_s_barrier()
#define PG8_SCHED __builtin_amdgcn_sched_barrier(0)
    Unit cur, nxt; int ui = 0;
    if (!S.next(0, cur)) return;
    f32x4 acc[2][2][4][2];
#pragma unroll
    for (int a = 0; a < 2; ++a)
#pragma unroll
        for (int b = 0; b < 2; ++b)
#pragma unroll
            for (int m = 0; m < 4; ++m)
#pragma unroll
                for (int n = 0; n < 2; ++n) acc[a][b][m][n] = zero4();
    bf16x8 At[4][2], B0[2][2], B1[2][2];
    const char* cA = (const char*)g.A + (size_t)cur.pm * tstepA; const char* cB = (const char*)g.Bt + (size_t)cur.pn * tstep;
    S.a_ready(cur);
    if constexpr (SP2) {
        PG8_STAGE(PG8_SB(0, 0), cB, voffB); PG8_STAGE(PG8_SB(0, 1), cB + hstep, voffB); PG8_STAGE(PG8_SA(0, 0), cA, voffA); PG8_STAGE(PG8_SA(0, 1), cA + hstepA, voffA);
        if (wr == 1) PG8_BAR;
        PG8_WAIT_V(2); PG8_BAR;
        PG8_STAGE(PG8_SB(1, 0), cB + kstep, voffB); PG8_STAGE(PG8_SA(1, 0), cA + kstep, voffA); PG8_STAGE(PG8_SB(1, 1), cB + hstep + kstep, voffB);
        PG8_WAIT_V(6); PG8_BAR;
    } else {
        PG8_STAGE(PG8_SB(0, 0), cB, voffB); PG8_STAGE(PG8_SA(0, 0), cA, voffA); PG8_STAGE(PG8_SB(0, 1), cB + hstep, voffB); PG8_STAGE(PG8_SA(0, 1), cA + hstepA, voffA);
        if (wr == 1) PG8_BAR;
        PG8_WAIT_V(4); PG8_BAR;
        PG8_STAGE(PG8_SB(1, 0), cB + kstep, voffB); PG8_STAGE(PG8_SA(1, 0), cA + kstep, voffA); PG8_STAGE(PG8_SB(1, 1), cB + hstep + kstep, voffB);
        PG8_WAIT_V(6); PG8_BAR;
    }
    for (;;) {
        const bool has_next = S.next(ui + 1, nxt);
        const char* nA = has_next ? (const char*)g.A + (size_t)nxt.pm * tstepA : cA; const char* nB = has_next ? (const char*)g.Bt + (size_t)nxt.pn * tstep : cB;
        for (int t = 0; t < nt; t += 2) {
            const bool last = (t == nt - 2);
            const char* a1 = cA + (size_t)(t + 1) * kstep;
            const char* a2 = last ? nA : cA + (size_t)(t + 2) * kstep; const char* b2 = last ? nB : cB + (size_t)(t + 2) * kstep;
            const char* a3 = a2 + kstep; const char* b3 = b2 + kstep;
            if (last && has_next) S.a_ready(nxt);
            if (last) E.pre(cur, wid, lane);
            if constexpr (SP2) {
            PG8_LDB(B0, 0, 0); PG8_LDB(B1, 0, 1); PG8_SCHED; PG8_LDA(At, 0, 0); PG8_STAGE(PG8_SA(1, 1), a1 + hstepA, voffA);
            PG8_WAIT_V(8); PG8_WAIT_L(0); PG8_BAR; PG8_MMA(0, 0, At, B0); PG8_MMA(0, 1, At, B1); PG8_BAR; PG8_SCHED;
            PG8_LDA(At, 0, 1); PG8_STAGE(PG8_SB(0, 0), b2, voffB); PG8_STAGE(PG8_SB(0, 1), b2 + hstep, voffB); PG8_STAGE(PG8_SA(0, 0), a2, voffA);
            PG8_WAIT_V(8); PG8_WAIT_L(0); PG8_BAR; PG8_MMA(1, 0, At, B0); PG8_MMA(1, 1, At, B1); PG8_BAR; PG8_SCHED;
            PG8_LDB(B0, 1, 0); PG8_LDB(B1, 1, 1); PG8_SCHED; PG8_LDA(At, 1, 0); PG8_STAGE(PG8_SA(0, 1), a2 + hstepA, voffA);
            PG8_WAIT_V(8); PG8_WAIT_L(0); PG8_BAR; PG8_MMA(0, 0, At, B0); PG8_MMA(0, 1, At, B1); PG8_BAR; PG8_SCHED;
            PG8_LDA(At, 1, 1); PG8_STAGE(PG8_SB(1, 0), b3, voffB); PG8_STAGE(PG8_SB(1, 1), b3 + hstep, voffB); PG8_STAGE(PG8_SA(1, 0), a3, voffA);
            PG8_WAIT_V(8); PG8_WAIT_L(0); PG8_BAR; PG8_MMA(1, 0, At, B0); PG8_MMA(1, 1, At, B1); PG8_BAR; PG8_SCHED;
            } else {
            PG8_LDB(B0, 0, 0); PG8_SCHED; PG8_LDA(At, 0, 0); PG8_STAGE(PG8_SA(1, 1), a1 + hstepA, voffA);
            PG8_WAIT_L(8); PG8_BAR; PG8_WAIT_L(0); PG8_MMA(0, 0, At, B0); PG8_BAR; PG8_SCHED;
            PG8_LDB(B1, 0, 1); PG8_STAGE(PG8_SB(0, 0), b2, voffB);
            PG8_BAR; PG8_WAIT_L(0); PG8_MMA(0, 1, At, B1); PG8_BAR;
            PG8_LDA(At, 0, 1); PG8_STAGE(PG8_SA(0, 0), a2, voffA);
            PG8_BAR; PG8_WAIT_L(0); PG8_MMA(1, 0, At, B0); PG8_BAR; PG8_SCHED;
            PG8_STAGE(PG8_SB(0, 1), b2 + hstep, voffB);
            PG8_WAIT_V(6); PG8_BAR; PG8_MMA(1, 1, At, B1); PG8_BAR;
            PG8_LDB(B0, 1, 0); PG8_SCHED; PG8_LDA(At, 1, 0); PG8_STAGE(PG8_SA(0, 1), a2 + hstepA, voffA);
            PG8_WAIT_L(8); PG8_BAR; PG8_WAIT_L(0); PG8_MMA(0, 0, At, B0); PG8_BAR; PG8_SCHED;
            PG8_LDB(B1, 1, 1); PG8_STAGE(PG8_SB(1, 0), b3, voffB);
            PG8_BAR; PG8_WAIT_L(0); PG8_MMA(0, 1, At, B1); PG8_BAR;
            PG8_LDA(At, 1, 1); PG8_STAGE(PG8_SA(1, 0), a3, voffA);
            PG8_BAR; PG8_WAIT_L(0); PG8_MMA(1, 0, At, B0); PG8_BAR; PG8_SCHED;
            PG8_STAGE(PG8_SB(1, 1), b3 + hstep, voffB);
            PG8_WAIT_V(6); PG8_BAR; PG8_MMA(1, 1, At, B1); PG8_BAR;
            }
        }
        if constexpr (ALIGN_EPI) { if (wr == 0) PG8_BAR; }
        if constexpr (!Epi::AFTER_DRAIN) { E(acc, cur, wr, wc, fr, fq); S.done(cur); }
        if (!has_next) break;
#pragma unroll
        for (int a = 0; a < 2; ++a)
#pragma unroll
            for (int b = 0; b < 2; ++b)
#pragma unroll
                for (int m = 0; m < 4; ++m)
#pragma unroll
                    for (int n = 0; n < 2; ++n) acc[a][b][m][n] = zero4();
        cur = nxt; cA = nA; cB = nB; ++ui;
        if constexpr (ALIGN_EPI) { if (wr == 1) PG8_BAR; }
    }
    PG8_WAIT_V(0);
    if constexpr (!ALIGN_EPI) { if (wr == 0) PG8_BAR; }
    PG8_BAR;
    if constexpr (Epi::AFTER_DRAIN) { E.fused(acc, cur, wr, wc, fr, fq, lds, wid, lane); S.done(cur); }
#undef PG8_SA
#undef PG8_SB
#undef PG8_STAGE
#undef PG8_LDA
#undef PG8_LDB
#undef PG8_MMA
#undef PG8_WAIT_V
#undef PG8_WAIT_L
#undef PG8_BAR
#undef PG8_SCHED
}
}
constexpr int DM = 2048, NSEQ = 10, SEQL = 4096, M = NSEQ * SEQL, M_PROMPT = 8 * SEQL;
constexpr int DA = 1024, DB = 1024, DH = 128, HA = 8, DFF = 8192, DINAB = 6144, DC2 = 4096, DHALF = 3072;
constexpr int EMB = 33, FO = 64, KLEN = 2 * SEQL, RVF_PITCH = KLEN + 32;
constexpr float EPS = 1e-6f;
constexpr int NWAVES = 8, NTHR = 512;

constexpr size_t MiB = 1u << 20;
constexpr size_t WS_CTL = 0, CTL_ZERO_BYTES = 32 * 1024;
constexpr size_t WS_INVS = 1 * MiB + 768 * 1024;
constexpr size_t WS_WIN = 2 * MiB;
constexpr size_t WS_WOUT = 26 * MiB;
constexpr size_t WS_W1 = 34 * MiB;
constexpr size_t WS_W2 = 66 * MiB;
constexpr size_t WS_FILT = 98 * MiB;
constexpr size_t WS_XB = 130 * MiB;
constexpr size_t WS_BIG = 290 * MiB;
constexpr size_t WS_WIN2 = 930 * MiB;
constexpr size_t WS_WOUT2 = 954 * MiB;
constexpr size_t WS_SSA = 962 * MiB;
constexpr size_t WS_SSB = 968 * MiB;
constexpr size_t WS_RVS = 974 * MiB;
constexpr size_t WS_RVF = 980 * MiB;
constexpr size_t WS_END = 997 * MiB;
constexpr size_t BIG_PA = 0, BIG_PB = 240 * MiB, BIG_UT = 480 * MiB, BIG_X0T = 560 * MiB;

constexpr int CW_BAR = 4096;

constexpr int RING_BYTES = 131072;
constexpr int LDS_BYTES = 163840;
constexpr int MISC_OFF = LDS_BYTES - 128;

#define GAS __attribute__((address_space(1)))
#define LAS __attribute__((address_space(3)))
typedef unsigned short bf16;
typedef unsigned v4u __attribute__((ext_vector_type(4)));
typedef unsigned v2u __attribute__((ext_vector_type(2)));
typedef float f32x4 __attribute__((ext_vector_type(4)));
typedef GAS unsigned gu32;
typedef const GAS float* gcf; typedef GAS float* gf; typedef const GAS unsigned short* gcb; typedef GAS unsigned short* gb;
#define RLX_AGENT __ATOMIC_RELAXED, __HIP_MEMORY_SCOPE_AGENT
#define LDS_WAIT() asm volatile("s_waitcnt lgkmcnt(0)" ::: "memory")
#define VM_WAIT() asm volatile("s_waitcnt vmcnt(0)" ::: "memory")
__device__ __forceinline__ unsigned f2bf(float f) { unsigned u = __builtin_bit_cast(unsigned, f); return (u + 0x7fffu + ((u >> 16) & 1u)) >> 16; }
__device__ __forceinline__ unsigned pk2(float lo, float hi) { unsigned r; asm("v_cvt_pk_bf16_f32 %0, %1, %2" : "=v"(r) : "v"(lo), "v"(hi)); return r; }
__device__ __forceinline__ float bflo(unsigned w) { return __builtin_bit_cast(float, w << 16); }
__device__ __forceinline__ float bfhi(unsigned w) { return __builtin_bit_cast(float, w & 0xffff0000u); }
__device__ __forceinline__ float bf2f(bf16 v) { return __builtin_bit_cast(float, (unsigned)v << 16); }
template <int X> __device__ __forceinline__ float swz_xor(float v) { return __builtin_bit_cast(float, __builtin_amdgcn_ds_swizzle(__builtin_bit_cast(int, v), (X << 10) | 0x1F)); }
__device__ __forceinline__ float half_swap(float v) { const unsigned u = __builtin_bit_cast(unsigned, v); const auto q = __builtin_amdgcn_permlane32_swap(u, u, false, false);
    return __builtin_bit_cast(float, (unsigned)q[0]) + __builtin_bit_cast(float, (unsigned)q[1]) - v; }
__device__ __forceinline__ float wave_sum(float v) {
    v += swz_xor<1>(v); v += swz_xor<2>(v); v += swz_xor<4>(v); v += swz_xor<8>(v); v += swz_xor<16>(v);
    const unsigned u = __builtin_bit_cast(unsigned, v); const auto q = __builtin_amdgcn_permlane32_swap(u, u, false, false);
    return __builtin_bit_cast(float, (unsigned)q[0]) + __builtin_bit_cast(float, (unsigned)q[1]);
}

#define XB_TMO      128
#define XB_XCNT(j)  (256  + 64 * (j))
#define XB_XSUB(j)  (1280 + 64 * (j))
#define XB_XGEN(j)  (2304 + 64 * (j))
#define XB_TOP      3328
#define XB_TOPGEN   3392
#define XCD_BAR_WORDS 3456
#define XB_SPIN_CAP (1u << 22)

__device__ __forceinline__ unsigned xb_ld(unsigned* p)              { return __hip_atomic_load(p, __ATOMIC_RELAXED, __HIP_MEMORY_SCOPE_AGENT); }
__device__ __forceinline__ unsigned xb_add(unsigned* p, unsigned v) { return __hip_atomic_fetch_add(p, v, __ATOMIC_RELAXED, __HIP_MEMORY_SCOPE_AGENT); }
__device__ __forceinline__ unsigned xb_xcc_id() { return (unsigned)__builtin_amdgcn_s_getreg((3 << 11) | 20) & 0xFu; }
#define XB_SPIN(cond, bar) do { unsigned _sp = 0; while (cond) { __builtin_amdgcn_s_sleep(1); \
    if ((++_sp & 255u) == 0u) { if (xb_ld(&(bar)[XB_TMO])) break; if (_sp > XB_SPIN_CAP) { atomicAdd(&(bar)[XB_TMO], 1u); break; } } } } while (0)

struct XcdBarrier {
    unsigned* bar; unsigned x;
    volatile LAS unsigned* st;
};

__device__ __forceinline__ XcdBarrier xcd_barrier_post(unsigned* bar, volatile LAS unsigned* st) {
    XcdBarrier b; b.bar = bar; b.x = xb_xcc_id(); b.st = st;
    if (threadIdx.x == 0) (void)xb_add(&bar[XB_XCNT(b.x)], 1u);
    return b;
}
__device__ __forceinline__ void xcd_barrier_complete(unsigned* bar, unsigned x, unsigned& nloc, unsigned& nx) {
    const unsigned G = gridDim.x * gridDim.y * gridDim.z;
    unsigned sum, cnt, mine, sp = 0u;
    for (;;) {
        sum = 0u; cnt = 0u; mine = 0u;
#pragma unroll
        for (unsigned j = 0; j < 16; ++j) { const unsigned c = xb_ld(&bar[XB_XCNT(j)]); sum += c; cnt += (c > 0u) ? 1u : 0u; mine = (j == x) ? c : mine; }
        if (sum == G) break;
        __builtin_amdgcn_s_sleep(1);
        if ((++sp & 255u) == 0u) { if (xb_ld(&bar[XB_TMO])) break; if (sp > XB_SPIN_CAP) { atomicAdd(&bar[XB_TMO], 1u); break; } }
    }
    nloc = mine > 0u ? mine : 1u; nx = cnt > 0u ? cnt : 1u;
}

__device__ __forceinline__ void xcd_barrier(const XcdBarrier& b) {
    asm volatile("s_waitcnt vmcnt(0)" ::: "memory");
    __syncthreads();
    if (threadIdx.x == 0) {
        unsigned* bar = b.bar;
        __builtin_amdgcn_s_waitcnt(0);
        unsigned nloc = b.st[0], nx = b.st[1];
        if (nloc == 0u) { xcd_barrier_complete(bar, b.x, nloc, nx); b.st[0] = nloc; b.st[1] = nx; }
        const unsigned old = xb_add(&bar[XB_XSUB(b.x)], 1u);
        const unsigned gen = old / nloc;
        if (old + 1u == (gen + 1u) * nloc) {
            __builtin_amdgcn_fence(__ATOMIC_RELEASE, "agent");
            asm volatile("s_waitcnt vmcnt(0)" ::: "memory");
            const unsigned og = xb_add(&bar[XB_TOP], 1u);
            const unsigned tg = og / nx;
            if (og + 1u == (tg + 1u) * nx) xb_add(&bar[XB_TOPGEN], 1u);
            else XB_SPIN(xb_ld(&bar[XB_TOPGEN]) == tg, bar);
            __builtin_amdgcn_fence(__ATOMIC_ACQUIRE, "agent");
            xb_add(&bar[XB_XGEN(b.x)], 1u);
            asm volatile("s_waitcnt vmcnt(0)" ::: "memory");
        } else {
            XB_SPIN(xb_ld(&bar[XB_XGEN(b.x)]) == gen, bar);
            __builtin_amdgcn_fence(__ATOMIC_ACQUIRE, "agent");
            asm volatile("s_waitcnt vmcnt(0)" ::: "memory");
        }
    }
    __syncthreads();
}


struct Frame {
    LAS unsigned char* lds;
    volatile LAS unsigned* MISC;
    gu32* ctl;
    int tid, lane, wave;
    int vcu, G, bx, wbase;
    gcf xp, xs; gf out;
    GAS unsigned char* ws;
    gb W1, W2, XB;
    gf FILT, RVS, INVS; gb RVF, SSA, SSB;
};
struct Params { const float* in[27]; float* out; unsigned char* ws; int ph_lo, ph_hi; };

__device__ __forceinline__ gcf xrow_ptr(const Frame& F, int layer, int m) {
    if (layer == 0) return m < M_PROMPT ? F.xp + (size_t)m * DM : F.xs + (size_t)(m - M_PROMPT) * DM;
    return F.out + (size_t)m * DM;
}

__device__ __forceinline__ void xb_rows(Frame& F) {
    const int gw = F.vcu * NWAVES + F.wave, NGW = F.G * NWAVES;
    for (int m = gw; m < M; m += NGW) {
        const GAS f32x4* xr = (const GAS f32x4*)xrow_ptr(F, 0, m) + F.lane;
        f32x4 v[8]; float s = 0.f;
#pragma unroll
        for (int j = 0; j < 8; ++j) { v[j] = xr[64 * j]; s += (v[j].x * v[j].x + v[j].y * v[j].y) + (v[j].z * v[j].z + v[j].w * v[j].w); }
        s = wave_sum(s);
        GAS unsigned long long* o8 = (GAS unsigned long long*)(F.XB + (size_t)m * DM) + F.lane;
#pragma unroll
        for (int j = 0; j < 8; ++j) o8[64 * j] = (unsigned long long)pk2(v[j].x, v[j].y) | ((unsigned long long)pk2(v[j].z, v[j].w) << 32);
        { const float h0 = bfhi(pk2(0.f, s)), h1 = bfhi(pk2(0.f, s - h0)), h2 = s - h0 - h1;
          if (F.lane < 32) F.SSA[(size_t)m * 32 + F.lane] = (bf16)(pk2(F.lane == 0 ? h0 : (F.lane == 1 ? h1 : (F.lane == 2 ? h2 : 0.f)), 0.f) & 0xffffu); }
    }
}
__device__ __forceinline__ void zero_f32(Frame& F, gf p, int n) {
    for (int i = F.vcu * NTHR + F.tid; i < n / 4; i += F.G * NTHR) ((GAS f32x4*)p)[i] = pg8::zero4();
}
__device__ __forceinline__ void transpose_item(gcf W, gcf gain, int K, int N, gb WT, LAS float* scr, int item, int lane) {
    const int nblk = N / 64, kb = item / nblk, nb = item % nblk, k0 = 64 * kb, n0 = 64 * nb;
    const int lr = lane >> 4, lc = lane & 15;
    f32x4 v[16];
#pragma unroll
    for (int i = 0; i < 16; ++i) v[i] = *(const GAS f32x4*)(W + (size_t)(k0 + 4 * i + lr) * N + n0 + 4 * lc);
    float gk[16];
    if (gain) {
#pragma unroll
        for (int i = 0; i < 16; ++i) gk[i] = gain[k0 + 4 * i + lr];
    } else {
#pragma unroll
        for (int i = 0; i < 16; ++i) gk[i] = 1.0f;
    }
#pragma unroll
    for (int i = 0; i < 16; ++i) asm volatile("" : "+v"(gk[i]));
#pragma unroll
    for (int i = 0; i < 16; ++i) *(LAS f32x4*)(scr + (4 * i + lr) * 68 + 4 * lc) = v[i] * gk[i];
    LDS_WAIT(); asm volatile("" ::: "memory");
    const int kc = lane & 7, nr = lane >> 3;
#pragma unroll
    for (int j = 0; j < 8; ++j) { const int n = 8 * j + nr; const LAS float* s = scr + (8 * kc) * 68 + n;
        v4u o; o.x = pk2(s[0 * 68], s[1 * 68]); o.y = pk2(s[2 * 68], s[3 * 68]); o.z = pk2(s[4 * 68], s[5 * 68]); o.w = pk2(s[6 * 68], s[7 * 68]);
        *(GAS v4u*)(WT + (size_t)(n0 + n) * K + k0 + 8 * kc) = o; }
    LDS_WAIT(); asm volatile("" ::: "memory");
}
struct CvtJob { gcf W; gcf gain; gb T; int K, N; };
template <int NJ> __device__ __forceinline__ void convert_jobs(Frame& F, const CvtJob (&jobs)[NJ], int lds_off) {
    LAS float* scr = (LAS float*)(F.lds + lds_off + F.wave * 17408);
    const int gw = F.vcu * NWAVES + F.wave, NGW = F.G * NWAVES;
    int total = 0;
#pragma unroll
    for (int q = 0; q < NJ; ++q) total += (jobs[q].K / 64) * (jobs[q].N / 64);
    for (int it = gw; it < total; it += NGW) {
        int r = it;
#pragma unroll
        for (int q = 0; q < NJ; ++q) { const int I = (jobs[q].K / 64) * (jobs[q].N / 64);
            if (r >= 0 && r < I) transpose_item(jobs[q].W, jobs[q].gain, jobs[q].K, jobs[q].N, jobs[q].T, scr, r, F.lane);
            r -= I; }
    }
}

template <class P> __device__ __forceinline__ P unif_ptr(P p) { const unsigned long long v = (unsigned long long)p;
    const unsigned lo = __builtin_amdgcn_readfirstlane((unsigned)v), hi = __builtin_amdgcn_readfirstlane((unsigned)(v >> 32)); return (P)(((unsigned long long)hi << 32) | lo); }
__device__ __forceinline__ void filter_gen(Frame& F, gcf fw1v, gcf fb1v, gcf fw2v, gcf fb2v, gcf fw3v, gcf fb3v,
                                           gcf fwoutv, gcf ffreqv) {
    gcf fw1 = unif_ptr(fw1v), fb1 = unif_ptr(fb1v), fw2 = unif_ptr(fw2v), fb2 = unif_ptr(fb2v), fw3 = unif_ptr(fw3v), fb3 = unif_ptr(fb3v), fwout = unif_ptr(fwoutv), ffreq = unif_ptr(ffreqv);
    LAS float* zf = (LAS float*)(F.lds);
    LAS float* ha = zf + 16 * 36;
    LAS float* hb = ha + 16 * 64;
    for (int unit = F.bx; unit < SEQL / 16; unit += F.G) {
        const int t0 = unit * 16;
        __syncthreads();
        for (int e = F.tid; e < 16 * EMB; e += NTHR) {
            const int tl = e / EMB, k = e % EMB, t = t0 + tl;
            const float tlin = (float)t / (float)(SEQL - 1);
            const float w = 6.283185307179586f * (float)t / (float)SEQL;
            float z;
            if (k == 0) z = tlin;
            else { const int kk = (k - 1) & 15; const float fk = 1e-4f + (float)kk * ((15.0f - 1e-4f) / 15.0f); z = (k <= 16) ? cosf(fk * w) : -sinf(fk * w); }
            zf[tl * 36 + k] = z;
        }
        __syncthreads();
        static_assert(EMB % 11 == 0 && FO % 16 == 0 && NTHR == 8 * FO, "filter MLP load batches / thread map");
#define FG_MAP int ts_ = F.tid; asm volatile("" : "+v"(ts_)); const int o_ = ts_ & (FO - 1), tl0 = ts_ >> 6
        { FG_MAP; float s0 = fb1[o_], s1 = s0;
            for (int k0 = 0; k0 < EMB; k0 += 11) { float wv[11];
#pragma unroll
                for (int j = 0; j < 11; ++j) wv[j] = fw1[(k0 + j) * FO + o_];
#pragma unroll
                for (int j = 0; j < 11; ++j) asm volatile("" : "+v"(wv[j]));
#pragma unroll
                for (int j = 0; j < 11; ++j) { s0 += zf[tl0 * 36 + k0 + j] * wv[j]; s1 += zf[(tl0 + 8) * 36 + k0 + j] * wv[j]; } }
            const float fq_ = ffreq[o_]; ha[tl0 * FO + o_] = sinf(fq_ * s0); ha[(tl0 + 8) * FO + o_] = sinf(fq_ * s1); }
        __syncthreads();
        { FG_MAP; float s0 = fb2[o_], s1 = s0;
            for (int k0 = 0; k0 < FO; k0 += 16) { float wv[16];
#pragma unroll
                for (int j = 0; j < 16; ++j) wv[j] = fw2[(k0 + j) * FO + o_];
#pragma unroll
                for (int j = 0; j < 16; ++j) asm volatile("" : "+v"(wv[j]));
#pragma unroll
                for (int j = 0; j < 16; ++j) { s0 += ha[tl0 * FO + k0 + j] * wv[j]; s1 += ha[(tl0 + 8) * FO + k0 + j] * wv[j]; } }
            const float fq_ = ffreq[o_]; hb[tl0 * FO + o_] = sinf(fq_ * s0); hb[(tl0 + 8) * FO + o_] = sinf(fq_ * s1); }
        __syncthreads();
        { FG_MAP; float s0 = fb3[o_], s1 = s0;
            for (int k0 = 0; k0 < FO; k0 += 16) { float wv[16];
#pragma unroll
                for (int j = 0; j < 16; ++j) wv[j] = fw3[(k0 + j) * FO + o_];
#pragma unroll
                for (int j = 0; j < 16; ++j) asm volatile("" : "+v"(wv[j]));
#pragma unroll
                for (int j = 0; j < 16; ++j) { s0 += hb[tl0 * FO + k0 + j] * wv[j]; s1 += hb[(tl0 + 8) * FO + k0 + j] * wv[j]; } }
            const float fq_ = ffreq[o_]; ha[o_ * 16 + tl0] = sinf(fq_ * s0); ha[o_ * 16 + tl0 + 8] = sinf(fq_ * s1); }
        __syncthreads();
#undef FG_MAP
        for (int q = 0; q < 4; ++q) {
            int tq_ = F.tid; asm volatile("" : "+v"(tq_));
            const int o = tq_ + NTHR * q;
            float acc[16];
#pragma unroll
            for (int i = 0; i < 16; ++i) acc[i] = 0.f;
            for (int k0 = 0; k0 < FO; k0 += 16) { float wq[16];
#pragma unroll
              for (int j = 0; j < 16; ++j) wq[j] = fwout[(k0 + j) * (2 * DB) + o];
#pragma unroll
              for (int j = 0; j < 16; ++j) asm volatile("" : "+v"(wq[j]));
#pragma unroll
              for (int j = 0; j < 16; ++j) { const int k = k0 + j; const float wv = wq[j];
                const f32x4 h0 = *(const LAS f32x4*)(ha + k * 16), h1 = *(const LAS f32x4*)(ha + k * 16 + 4), h2 = *(const LAS f32x4*)(ha + k * 16 + 8), h3 = *(const LAS f32x4*)(ha + k * 16 + 12);
                acc[0] += h0[0] * wv; acc[1] += h0[1] * wv; acc[2] += h0[2] * wv; acc[3] += h0[3] * wv; acc[4] += h1[0] * wv; acc[5] += h1[1] * wv; acc[6] += h1[2] * wv; acc[7] += h1[3] * wv;
                acc[8] += h2[0] * wv; acc[9] += h2[1] * wv; acc[10] += h2[2] * wv; acc[11] += h2[3] * wv; acc[12] += h3[0] * wv; acc[13] += h3[1] * wv; acc[14] += h3[2] * wv; acc[15] += h3[3] * wv; } }
            const int c = o & (DB - 1);
            const float dlo = -15.350567286626973f, dhi = -3.0701134573253945f;
            const float delta = fabsf(dlo + (float)c * ((dhi - dlo) / (float)(DB - 1)));
            gf frow = F.FILT + (size_t)c * KLEN;
            gb rrow = F.RVF + (size_t)c * RVF_PITCH;
            float v[16];
#pragma unroll
            for (int i = 0; i < 16; ++i) { const int t = t0 + i; const float tlin = (float)t / (float)(SEQL - 1); v[i] = acc[i] * expf(-tlin * delta); }
            if (o < DB) {
#pragma unroll
                for (int i4 = 0; i4 < 4; ++i4) *(GAS f32x4*)(frow + t0 + 4 * i4) = (f32x4){v[4 * i4], v[4 * i4 + 1], v[4 * i4 + 2], v[4 * i4 + 3]};
                gb rs_ = rrow + (SEQL - t0);
                rs_[0] = (bf16)f2bf(v[0]);
                *(GAS v4u*)(rs_ - 8) = (v4u){pk2(v[8], v[7]), pk2(v[6], v[5]), pk2(v[4], v[3]), pk2(v[2], v[1])};
                *(GAS v2u*)(rs_ - 12) = (v2u){pk2(v[12], v[11]), pk2(v[10], v[9])};
                *(GAS unsigned*)(rs_ - 14) = pk2(v[14], v[13]);
                rs_[-15] = (bf16)f2bf(v[15]);
            } else {
                gf fs_ = frow + (KLEN - t0);
                *(GAS f32x4*)(fs_ - 4) = (f32x4){v[4], v[3], v[2], v[1]};
                *(GAS f32x4*)(fs_ - 8) = (f32x4){v[8], v[7], v[6], v[5]};
                *(GAS f32x4*)(fs_ - 12) = (f32x4){v[12], v[11], v[10], v[9]};
                *(GAS v2u*)(fs_ - 14) = (v2u){__builtin_bit_cast(unsigned, v[14]), __builtin_bit_cast(unsigned, v[13])};
                fs_[-15] = v[15];
                gb rs_ = rrow + (SEQL + t0);
                *(GAS v4u*)(rs_ + 8) = (v4u){pk2(v[8], v[9]), pk2(v[10], v[11]), pk2(v[12], v[13]), pk2(v[14], v[15])};
                if (t0 > 0) { fs_[0] = v[0]; *(GAS v4u*)rs_ = (v4u){pk2(v[0], v[1]), pk2(v[2], v[3]), pk2(v[4], v[5]), pk2(v[6], v[7])}; }
                else { frow[SEQL] = 0.f; rrow[0] = 0;
#pragma unroll
                    for (int i = 1; i < 8; ++i) rs_[i] = (bf16)f2bf(v[i]); }
            }
            if (unit == 0 && o < DB) {
#pragma unroll
                for (int i4 = 0; i4 < 4; ++i4) *(GAS v4u*)(rrow + KLEN + 8 * i4) = (v4u){0u, 0u, 0u, 0u};
            }
        }
    }
}

struct PrepRegs { v4u x[3][3]; };
__device__ __forceinline__ void prep_load(PrepRegs& R, gcb PB, int cb, int bt, int tl, int cv) {
    const int b = bt >> 6, tb = bt & 63, t = tb * 64 + tl, c = cb * 64 + 8 * cv;
    gcb p = PB + ((size_t)b * SEQL + t) * DHALF + c;
#pragma unroll
    for (int part = 0; part < 3; ++part) {
        R.x[part][0] = (t > 0) ? *(const GAS v4u*)(p + part * DB - DHALF) : (v4u){0u, 0u, 0u, 0u};
        R.x[part][1] = *(const GAS v4u*)(p + part * DB);
        R.x[part][2] = (t < SEQL - 1) ? *(const GAS v4u*)(p + part * DB + DHALF) : (v4u){0u, 0u, 0u, 0u};
    }
}
struct PrepW { f32x4 w[3][2]; f32x4 b[2]; };
__device__ __forceinline__ void prep_weights(PrepW& W, gcf scw, gcf scb, int col) {
#pragma unroll
    for (int k = 0; k < 3; ++k) { W.w[k][0] = *(const GAS f32x4*)(scw + k * DHALF + col); W.w[k][1] = *(const GAS f32x4*)(scw + k * DHALF + col + 4); }
    W.b[0] = *(const GAS f32x4*)(scb + col); W.b[1] = *(const GAS f32x4*)(scb + col + 4);
}
__device__ __forceinline__ void conv8(float (&z)[8], const v4u (&x)[3], const PrepW& W) {
#pragma unroll
    for (int e = 0; e < 8; ++e) z[e] = (e < 4) ? W.b[0][e] : W.b[1][e - 4];
#pragma unroll
    for (int k = 0; k < 3; ++k) { const v4u v = x[k];
        z[0] += bflo(v.x) * W.w[k][0][0]; z[1] += bfhi(v.x) * W.w[k][0][1]; z[2] += bflo(v.y) * W.w[k][0][2]; z[3] += bfhi(v.y) * W.w[k][0][3];
        z[4] += bflo(v.z) * W.w[k][1][0]; z[5] += bfhi(v.z) * W.w[k][1][1]; z[6] += bflo(v.w) * W.w[k][1][2]; z[7] += bfhi(v.w) * W.w[k][1][3]; }
}
__device__ __forceinline__ void hyena_prep(Frame& F, gcb PB, gb UT, gb X0T, gcf scw, gcf scb) {
    LAS bf16* tu = (LAS bf16*)(F.lds);
    LAS bf16* tx = tu + 64 * 72;
    const int tl = F.tid >> 3, cv = F.tid & 7;
    const int NBT = NSEQ * 64, nb = F.G >> 4, cb = F.bx & 15;
    if ((F.G & 15) != 0 || nb == 0) return;
    PrepW W0, W1, W2;
    prep_weights(W0, scw, scb, cb * 64 + 8 * cv); prep_weights(W1, scw, scb, DB + cb * 64 + 8 * cv); prep_weights(W2, scw, scb, 2 * DB + cb * 64 + 8 * cv);
    int bt = F.bx >> 4;
    PrepRegs R;
    if (bt < NBT) prep_load(R, PB, cb, bt, tl, cv);
    for (; bt < NBT; bt += nb) {
        float z0[8], z1[8], z2[8];
        conv8(z0, R.x[0], W0); conv8(z1, R.x[1], W1); conv8(z2, R.x[2], W2);
        if (bt + nb < NBT) prep_load(R, PB, cb, bt + nb, tl, cv);
        __syncthreads();
#pragma unroll
        for (int e = 0; e < 8; ++e) { tu[(8 * cv + e) * 72 + tl] = (bf16)f2bf(z2[e] * z1[e]); tx[(8 * cv + e) * 72 + tl] = (bf16)f2bf(z0[e]); }
        __syncthreads();
        const int cl = F.tid >> 3, tc = F.tid & 7, b = bt >> 6, tb = bt & 63;
        const size_t o = ((size_t)(cb * 64 + cl) * NSEQ + b) * SEQL + tb * 64 + 8 * tc;
        *(GAS v4u*)(UT + o) = *(const LAS v4u*)(tu + cl * 72 + 8 * tc);
        *(GAS v4u*)(X0T + o) = *(const LAS v4u*)(tx + cl * 72 + 8 * tc);
    }
}
__device__ __forceinline__ void filter_norm(Frame& F) {
    const int gw = F.vcu * NWAVES + F.wave, NGW = F.G * NWAVES;
    for (int c = gw; c < DB; c += NGW) {
        const GAS f32x4* p = (const GAS f32x4*)(F.FILT + (size_t)c * KLEN) + F.lane; float s = 0.f;
        for (int j0 = 0; j0 < KLEN / 256; j0 += 16) { f32x4 v[16];
#pragma unroll
            for (int j = 0; j < 16; ++j) v[j] = p[64 * (j0 + j)];
#pragma unroll
            for (int j = 0; j < 16; ++j) asm volatile("" : "+v"(v[j]));
#pragma unroll
            for (int j = 0; j < 16; ++j) s += (fabsf(v[j].x) + fabsf(v[j].y)) + (fabsf(v[j].z) + fabsf(v[j].w)); }
        s = wave_sum(s);
        if (F.lane == 0) F.INVS[c] = 1.f / s;
    }
}
constexpr int HY_C_OFF = 92416;
constexpr int HY_CS = 8704;
constexpr int HY_Z_OFF = HY_C_OFF + 8 * HY_CS;
static_assert(HY_Z_OFF + 128 <= MISC_OFF, "hyena LDS map");
typedef short bf16x8_t __attribute__((ext_vector_type(8)));
template <bool PRE>
__device__ __forceinline__ void hyena_build_copies(Frame& F, gcb rv, int zmin, int nz, v4u A0 = (v4u){0u, 0u, 0u, 0u}, v4u B0 = (v4u){0u, 0u, 0u, 0u}) {
    for (int zi = F.tid; zi < nz; zi += NTHR) {
        gcb p = rv + SEQL + zmin + 8 * zi;
        v4u A, B;
        if (PRE && zi < NTHR) { A = A0; B = B0; } else { A = *(const GAS v4u*)p; B = *(const GAS v4u*)(p + 8); }
        const unsigned d[8] = {A.x, A.y, A.z, A.w, B.x, B.y, B.z, B.w};
#pragma unroll
        for (int s = 0; s < 8; ++s) {
            v4u o;
            if ((s & 1) == 0) { o.x = d[s / 2]; o.y = d[s / 2 + 1]; o.z = d[s / 2 + 2]; o.w = d[s / 2 + 3]; }
            else { const int q = (s - 1) / 2;
                o.x = __builtin_amdgcn_alignbit(d[q + 1], d[q], 16); o.y = __builtin_amdgcn_alignbit(d[q + 2], d[q + 1], 16);
                o.z = __builtin_amdgcn_alignbit(d[q + 3], d[q + 2], 16); o.w = __builtin_amdgcn_alignbit(d[q + 4], d[q + 3], 16); }
            *(LAS v4u*)(F.lds + HY_C_OFF + s * HY_CS + 16 * ((0xC0B6E590u >> (4 * s)) & 15u) + 16 * zi) = o;
        }
    }
}
__device__ __forceinline__ void hyena_conv_mfma(Frame& F, gcb UT, gcb X0T, gb GT, gcf hbias) {
    const int lane = F.lane, w = F.wave, m = lane & 15, g = lane >> 4;
    const int sh = (-m) & 7, cc = (m + 7) >> 3;
    const unsigned copyb = HY_C_OFF + sh * HY_CS + 16 * ((0xC0B6E590u >> (4 * sh)) & 15u);
    const int pb = 14 - 2 * w, sb = 8 * w;
    const int dP = m >> 3, dS = m >> 1;
    const unsigned laneBP = (m & 7) * 8192 + 16 * (g ^ (m & 7)), laneBS = (8 + (m & 1)) * 8192, gxS = 16 * (g ^ (m & 1));
    const unsigned zb = HY_Z_OFF + 16 * g;
    for (int c = F.bx; c < DB; c += F.G) {
        gcb rvc = F.RVF + (size_t)c * RVF_PITCH;
        __syncthreads();
        if (F.tid < 8) *(LAS f32x4*)(F.lds + HY_Z_OFF + 16 * F.tid) = pg8::zero4();
        v4u rA, rB;
        { const GAS v4u* src = (const GAS v4u*)(UT + (size_t)c * NSEQ * SEQL);
          int ts = F.tid; asm volatile("" : "+v"(ts));
          const unsigned blk = ts >> 3, chk = ts & 7, fs = ((blk >> 1) & 3) << 1;
          v4u ur[NSEQ];
#pragma unroll
          for (int b = 0; b < NSEQ; ++b) ur[b] = src[b * 512 + ts];
          rA = *(const GAS v4u*)(rvc + SEQL - 4096 + 8 * ts); rB = *(const GAS v4u*)(rvc + SEQL - 4096 + 8 * ts + 8);
          __builtin_amdgcn_sched_barrier(0);
#pragma unroll
          for (int b = 0; b < NSEQ; ++b) { const unsigned f = (b < 8) ? (unsigned)b : ((unsigned)(b & 1) ^ fs); *(LAS v4u*)(F.lds + b * 8192 + blk * 128 + 16 * (chk ^ f)) = ur[b]; } }
        hyena_build_copies<true>(F, rvc, -4096, 520, rA, rB);
        __syncthreads();
        f32x4 acc[5][4];
#pragma unroll
        for (int i = 0; i < 5; ++i)
#pragma unroll
            for (int mt = 0; mt < 4; ++mt) acc[i][mt] = pg8::zero4();
        bf16x8_t A[4][2], An[4][2];
        v4u Bc0, Bc1, Bn0, Bn1, Bs0, Bs1;
#define HY_LDA(dst, base) do { _Pragma("unroll") for (int mt = 0; mt < 4; ++mt) _Pragma("unroll") for (int ks = 0; ks < 2; ++ks) \
            dst[mt][ks] = *(const LAS bf16x8_t*)(F.lds + (base) + (96 - 32 * mt + 64 * ks)); } while (0)
#define HY_LPC(buf, ap) do { const int ab_ = (ap) + dP; const unsigned bo_ = ((unsigned)ab_ < 64u) ? laneBP + 128u * (unsigned)ab_ : zb; \
            buf##0 = *(const LAS v4u*)(F.lds + bo_); buf##1 = *(const LAS v4u*)(F.lds + (bo_ ^ 64u)); __builtin_amdgcn_sched_barrier(0); } while (0)
#define HY_LPU(buf, off) do { buf##0 = *(const LAS v4u*)(F.lds + bq0 + (off)); buf##1 = *(const LAS v4u*)(F.lds + bq1 + (off)); __builtin_amdgcn_sched_barrier(0); } while (0)
#define HY_LS(buf, ap) do { const int ab_ = (ap) + dS; const unsigned bo_ = ((unsigned)ab_ < 64u) ? laneBS + 128u * (unsigned)ab_ + (gxS ^ (((unsigned)ab_ << 4) & 0x60u)) : zb; \
            buf##0 = *(const LAS v4u*)(F.lds + bo_); buf##1 = *(const LAS v4u*)(F.lds + (bo_ ^ 64u)); } while (0)
#define HY_MM(AA, i, buf) do { const bf16x8_t B0_ = __builtin_bit_cast(bf16x8_t, buf##0), B1_ = __builtin_bit_cast(bf16x8_t, buf##1); \
            _Pragma("unroll") for (int mt = 0; mt < 4; ++mt) acc[i][mt] = __builtin_amdgcn_mfma_f32_16x16x32_bf16(AA[mt][0], B0_, acc[i][mt], 0, 0, 0); \
            _Pragma("unroll") for (int mt = 0; mt < 4; ++mt) acc[i][mt] = __builtin_amdgcn_mfma_f32_16x16x32_bf16(AA[mt][1], B1_, acc[i][mt], 0, 0, 0); } while (0)
        {
            const unsigned laneA0 = copyb + 16 * g - 16 * cc + 8192 - 96;
            const int limS = sb + 7;
            int E = 0;
            HY_LDA(A, laneA0);
            HY_LPC(Bc, pb + 48);
            unsigned bq0 = laneBP + 128u * (unsigned)(pb + 15 + dP), bq1 = bq0 ^ 64u;
#define HY_TOP(Y, E_) HY_LDA(Y, laneA0 - 128 * min((E_) + 1, 63)); const bool sa_ = (E_) <= limS; if (sa_) HY_LS(Bs, sb - (E_))
#define HY_END(X) if (sa_) HY_MM(X, 4, Bs)
#define HY_DEC bq0 -= 128u; bq1 -= 128u
#define HY_S0(X, Y, P, Q, E_) { HY_TOP(Y, E_); HY_LPU(Q, 2176); HY_MM(X, 3, P); HY_LPU(P, 128); HY_MM(X, 2, Q); HY_LPC(Q, pb - (E_)); HY_MM(X, 1, P); HY_LPU(P, 4096); HY_MM(X, 0, Q); HY_END(X); HY_DEC; }
#define HY_S1(X, Y, P, Q, E_) { HY_TOP(Y, E_); HY_LPU(Q, 128); HY_MM(X, 3, P); HY_LPC(P, pb + 16 - (E_)); HY_MM(X, 2, Q); HY_LPU(Q, 2048); HY_MM(X, 1, P); HY_END(X); HY_DEC; }
#define HY_S2(X, Y, P, Q, E_) { HY_TOP(Y, E_); HY_LPC(Q, pb + 32 - (E_)); HY_MM(X, 3, P); HY_LPU(P, 0); HY_MM(X, 2, Q); HY_END(X); HY_DEC; }
#define HY_S3(X, Y, P, Q, E_) { HY_TOP(Y, E_); HY_LPC(Q, pb + 47 - (E_)); HY_MM(X, 3, P); HY_END(X); }
#define HY_ST(X, Y, P, Q, E_) { HY_LDA(Y, laneA0 - 128 * min((E_) + 1, 63)); HY_LS(Q, sb - (E_) - 1); HY_MM(X, 4, P); }
            for (; E <= pb + 1; E += 2) { HY_S0(A, An, Bc, Bn, E) HY_S0(An, A, Bc, Bn, E + 1) }
            bq0 += 2048u; bq1 += 2048u;
            for (; E <= pb + 17; E += 2) { HY_S1(A, An, Bc, Bn, E) HY_S1(An, A, Bn, Bc, E + 1) }
            bq0 += 2048u; bq1 += 2048u;
            for (; E <= pb + 33; E += 2) { HY_S2(A, An, Bc, Bn, E) HY_S2(An, A, Bc, Bn, E + 1) }
            for (; E <= pb + 49; E += 2) { HY_S3(A, An, Bc, Bn, E) HY_S3(An, A, Bn, Bc, E + 1) }
            HY_LS(Bc, sb - E);
            for (; E <= limS; E += 2) { HY_ST(A, An, Bc, Bn, E) HY_ST(An, A, Bn, Bc, E + 1) }
#undef HY_TOP
#undef HY_DEC
#undef HY_S0
#undef HY_S1
#undef HY_S2
#undef HY_S3
#undef HY_ST
        }
        __syncthreads();
          hyena_build_copies<false>(F, rvc, 0, 512);
        __syncthreads();
        {
            const unsigned laneA0 = copyb + 16 * g - 16 * cc - 96;
            const int limS = 63 - sb;
            int e = 1;
            HY_LDA(An, laneA0 + 128);
            HY_LPC(Bc, pb + 1);
            unsigned bq0 = laneBP + 128u * (unsigned)(pb + 1 + dP), bq1 = bq0 ^ 64u;
#define HY_TOP(Y, e_) HY_LDA(Y, laneA0 + 128 * min((e_) + 1, 63)); const bool sa_ = (e_) <= limS; if (sa_) HY_LS(Bs, sb + (e_))
#define HY_INC bq0 += 128u; bq1 += 128u
#define HY_P0(X, Y, P, Q, e_) { HY_TOP(Y, e_); HY_LPU(Q, 2048); HY_MM(X, 0, P); HY_LPU(P, 4096); HY_MM(X, 1, Q); HY_LPC(Q, pb + 48 + (e_)); HY_MM(X, 2, P); HY_LPU(P, 128); HY_MM(X, 3, Q); HY_END(X); HY_INC; }
#define HY_P1(X, Y, P, Q, e_) { HY_TOP(Y, e_); HY_LPU(Q, 2048); HY_MM(X, 0, P); HY_LPC(P, pb + 32 + (e_)); HY_MM(X, 1, Q); HY_LPU(Q, 128); HY_MM(X, 2, P); HY_END(X); HY_INC; }
#define HY_P2(X, Y, P, Q, e_) { HY_TOP(Y, e_); HY_LPC(Q, pb + 16 + (e_)); HY_MM(X, 0, P); HY_LPU(P, 128); HY_MM(X, 1, Q); HY_END(X); HY_INC; }
#define HY_P3(X, Y, P, Q, e_) { HY_TOP(Y, e_); HY_LPC(Q, pb + 1 + (e_)); HY_MM(X, 0, P); HY_END(X); }
#define HY_PT(X, Y, P, Q, e_) { HY_LDA(Y, laneA0 + 128 * min((e_) + 1, 63)); HY_LS(Q, sb + (e_) + 1); HY_MM(X, 4, P); }
            HY_P0(An, A, Bc, Bn, e) ++e;
            for (; e <= 15 - pb; e += 2) { HY_P0(A, An, Bc, Bn, e) HY_P0(An, A, Bc, Bn, e + 1) }
            for (; e <= 31 - pb; e += 2) { HY_P1(A, An, Bc, Bn, e) HY_P1(An, A, Bn, Bc, e + 1) }
            for (; e <= 47 - pb; e += 2) { HY_P2(A, An, Bc, Bn, e) HY_P2(An, A, Bc, Bn, e + 1) }
            for (; e <= 63 - pb; e += 2) { HY_P3(A, An, Bc, Bn, e) HY_P3(An, A, Bn, Bc, e + 1) }
            HY_LS(Bc, sb + e);
            for (; e <= limS; e += 2) { HY_PT(A, An, Bc, Bn, e) HY_PT(An, A, Bn, Bc, e + 1) }
#undef HY_TOP
#undef HY_INC
#undef HY_P0
#undef HY_P1
#undef HY_P2
#undef HY_P3
#undef HY_PT
        }
#undef HY_END
#undef HY_LDA
#undef HY_LPC
#undef HY_LPU
#undef HY_LS
#undef HY_MM
        {
            const float is = F.INVS[c], hb = hbias[c];
            int le = F.lane; asm volatile("" : "+v"(le));
            const int m = le & 15, g = le >> 4, dP = m >> 3, dS = m >> 1;
            const int sblk = sb + dS;
            const size_t oP = ((size_t)c * NSEQ + (m & 7)) * SEQL + 64 * (pb + dP) + 4 * g, oS = ((size_t)c * NSEQ + 8 + (m & 1)) * SEQL + 64 * sblk + 4 * g;
            const unsigned uPo = (m & 7) * 8192 + (pb + dP) * 128 + 8 * (g & 1), qP = 16 * ((g >> 1) ^ (m & 7));
            const unsigned uSo = (8 + (m & 1)) * 8192 + sblk * 128 + 8 * (g & 1), qS = 16 * ((g >> 1) ^ (m & 1) ^ (((sblk >> 1) & 3) << 1));
            v2u xq[5][4];
#pragma unroll
            for (int i = 0; i < 5; ++i)
#pragma unroll
                for (int mt = 0; mt < 4; ++mt) xq[i][mt] = *(const GAS v2u*)(X0T + ((i < 4) ? oP + 1024 * i + 16 * mt : oS + 16 * mt));
            __builtin_amdgcn_sched_barrier(0);
#pragma unroll
            for (int i = 0; i < 5; ++i)
#pragma unroll
                for (int mt = 0; mt < 4; ++mt) {
                    const size_t o = (i < 4) ? oP + 1024 * i + 16 * mt : oS + 16 * mt;
                    const unsigned up = (i < 4) ? uPo + 2048 * i + (qP ^ (32 * mt)) : uSo + (qS ^ (32 * mt));
                    const v2u xv = xq[i][mt];
                    const v2u uv = *(const LAS v2u*)(F.lds + up);
                    const f32x4 a4 = acc[i][mt];
                    const float y0 = (a4.x * is + bflo(uv.x) * hb) * bflo(xv.x), y1 = (a4.y * is + bfhi(uv.x) * hb) * bfhi(xv.x);
                    const float y2 = (a4.z * is + bflo(uv.y) * hb) * bflo(xv.y), y3 = (a4.w * is + bfhi(uv.y) * hb) * bfhi(xv.y);
                    *(GAS v2u*)(GT + o) = (v2u){pk2(y0, y1), pk2(y2, y3)};
                }
        }
    }
}
__device__ __forceinline__ void hyena_post(Frame& F, gcb GT, gb O, int ldo) {
    LAS bf16* tl_ = (LAS bf16*)(F.lds);
    for (int unit = F.bx; unit < NSEQ * 64 * 16; unit += F.G) {
        const int cb = unit / (NSEQ * 64), rem = unit % (NSEQ * 64), b = rem >> 6, tb = rem & 63;
        const int cl = F.tid >> 3, tc = F.tid & 7;
        const v4u v = *(const GAS v4u*)(GT + ((size_t)(cb * 64 + cl) * NSEQ + b) * SEQL + tb * 64 + 8 * tc);
        __syncthreads();
        tl_[(8 * tc + 0) * 72 + cl] = (bf16)(v.x & 0xffffu); tl_[(8 * tc + 1) * 72 + cl] = (bf16)(v.x >> 16);
        tl_[(8 * tc + 2) * 72 + cl] = (bf16)(v.y & 0xffffu); tl_[(8 * tc + 3) * 72 + cl] = (bf16)(v.y >> 16);
        tl_[(8 * tc + 4) * 72 + cl] = (bf16)(v.z & 0xffffu); tl_[(8 * tc + 5) * 72 + cl] = (bf16)(v.z >> 16);
        tl_[(8 * tc + 6) * 72 + cl] = (bf16)(v.w & 0xffffu); tl_[(8 * tc + 7) * 72 + cl] = (bf16)(v.w >> 16);
        __syncthreads();
        const int tl = F.tid >> 3, cc = F.tid & 7;
        *(GAS v4u*)(O + ((size_t)b * SEQL + tb * 64 + tl) * ldo + cb * 64 + 8 * cc) = *(const LAS v4u*)(tl_ + tl * 72 + 8 * cc);
    }
}
typedef short s16x4_t __attribute__((ext_vector_type(4)));
template <int NCH> __device__ __forceinline__ unsigned img_off(unsigned row, unsigned ch) { return (128u * NCH) * (row >> 3) + 512u * (ch >> 2) + 64u * (row & 7) + 16u * ((ch & 3) ^ ((row >> 2) & 3)); }
__device__ __forceinline__ s16x4_t ds_tr(const LAS unsigned char* p) { return __builtin_bit_cast(s16x4_t, __builtin_amdgcn_ds_read_tr16_b64_v4i16((LAS s16x4_t*)p)); }
__device__ __forceinline__ float sumsq8(v4u v) {
    const float a0 = bflo(v.x), a1 = bfhi(v.x), a2 = bflo(v.y), a3 = bfhi(v.y), a4 = bflo(v.z), a5 = bfhi(v.z), a6 = bflo(v.w), a7 = bfhi(v.w);
    return ((a0 * a0 + a1 * a1) + (a2 * a2 + a3 * a3)) + ((a4 * a4 + a5 * a5) + (a6 * a6 + a7 * a7));
}
constexpr int AT_RING = 0, AT_RKT = 9 * 16384, AT_RPB = AT_RKT + 2 * 2304, AT_GN = AT_RPB + 2 * 1920;
static_assert(AT_GN + 512 <= MISC_OFF, "attention LDS map");
#define AT_WAIT(n) asm volatile("s_waitcnt vmcnt(" #n ")" ::: "memory")
#define AT_BAR() do { asm volatile("s_waitcnt lgkmcnt(0)" ::: "memory"); __builtin_amdgcn_s_barrier(); asm volatile("" ::: "memory"); } while (0)
struct AtUnit { int b, h, r0, rs0; };
__device__ __forceinline__ AtUnit at_unit(int wu) { AtUnit u; u.b = wu >> 8; u.h = (wu >> 5) & 7; u.r0 = 2 * (wu & 31); u.rs0 = min(max(u.r0 - 4, 0), 56); return u; }
__device__ __forceinline__ void attn_coop(Frame& F, gcb PAv, gb O0v, int ldo, gcf qgv, gcf kgv, gcf rpbv, gcf RKPv) {
    const int w = F.wave;
    gcb PA_ = unif_ptr(PAv); gb O0_ = unif_ptr(O0v); gcf qg_ = unif_ptr(qgv), kg_ = unif_ptr(kgv), rpb_ = unif_ptr(rpbv), RKP_ = unif_ptr(RKPv);
    asm volatile("" : "+s"(PA_), "+s"(O0_), "+s"(qg_), "+s"(kg_), "+s"(rpb_), "+s"(RKP_));
    const int per = (NSEQ * HA * 32 + F.G - 1) / F.G, NUN = NSEQ * HA * 32;
#define AT_WU(k) ((F.G == 256) ? (F.vcu >> 5) * (32 * per) + 32 * (k) + (F.vcu & 31) : F.vcu * per + (k))
#define AT_OFFS(ln_) unsigned offK[2], offV[2]; \
    _Pragma("unroll") for (int i = 0; i < 2; ++i) { const int q = 2 * w + i; \
        const int rho = 4 * q + ((ln_) >> 4), ch = ((ln_) & 15) ^ (rho & 15); \
        const int rg = q >> 1, c4 = 2 * (q & 1) + ((ln_) >> 5), r7 = ((ln_) & 31) >> 2, row = 8 * rg + r7, chv = 4 * c4 + (((ln_) & 3) ^ ((row >> 2) & 3)); \
        offK[i] = (unsigned)(rho * DHALF + DA + 8 * ch); offV[i] = (unsigned)(row * DHALF + 2 * DA + 8 * chv); }
#define AT_BASE(U) (PA + ((size_t)(U).b * SEQL + (U).rs0 * 64) * DHALF + (U).h * DH)
#define AT_ISSUE(base, off, rs0_, j) do { const int jj_ = min((j), 63 - (rs0_)); _Pragma("unroll") for (int i = 0; i < 2; ++i) \
            __builtin_amdgcn_global_load_lds((const GAS unsigned*)((base) + (size_t)jj_ * 64 * DHALF + off[i]), (LAS unsigned*)(F.lds + AT_RING + (j) * 16384 + 1024 * (2 * w + i)), 16, 0, 0); } while (0)
    if (AT_WU(0) >= NUN) return;
    { gcb PA = PA_; const AtUnit u0 = at_unit(AT_WU(0)); gcb b0 = AT_BASE(u0); const int l0_ = pg8::lane_id_asm(); AT_OFFS(l0_); (void)offV;
      __syncthreads();
      if (F.tid < DH) ((LAS float*)(F.lds + AT_GN))[F.tid] = qg_[F.tid] * kg_[F.tid];
      __syncthreads();
#pragma unroll
      for (int j = 0; j < 9; ++j) AT_ISSUE(b0, offK, u0.rs0, j); }
    for (int k = 0; k < per; ++k) {
        const int wu = AT_WU(k);
        if (wu >= NUN) break;
        const bool has_next = (k + 1 < per) && (AT_WU(k + 1) < NUN);
        const int lane = pg8::lane_id_asm();
        gcb PA = PA_; gb O_ = O0_; gcf qg = qg_, kg = kg_, rpb = rpb_, RKP = RKP_;
        asm volatile("" : "+s"(PA), "+s"(O_), "+s"(qg), "+s"(kg), "+s"(rpb), "+s"(RKP));
        const int m = lane & 15, g = lane >> 4, lq = m >> 2, lp = lane & 3;
        AT_OFFS(lane);
        const AtUnit U = at_unit(wu);
        const int b = U.b, h = U.h, r0 = U.r0, rs0 = U.rs0, r = r0 + (w >> 2), c0 = 16 * (w & 3);
        const int rs = min(max(r - 4, 0), 56), kc0 = min(max(c0 - 8, 0), 32), ro = rs - rs0;
        const size_t tokb = (size_t)b * SEQL;
        gcb baseU = AT_BASE(U);
        LAS float* rkt = (LAS float*)(F.lds + AT_RKT) + (k & 1) * 576;
        for (int e = 64 * w + lane; e < 576; e += NTHR) { const int krow = min(rs0 + (e >> 6), 63);
            const f32x4 p4 = *(const GAS f32x4*)(RKP + (tokb + krow * 64 + (e & 63)) * 32 + h * 4);
            rkt[e] = rsqrtf(((p4.x + p4.y) + (p4.z + p4.w)) * (1.f / DH) + EPS); }
        const LAS float* rkw = rkt + ro * 64 + kc0 + 4 * g;
        LAS float* rpt = (LAS float*)(F.lds + AT_RPB) + (k & 1) * 480;
        { const int e = 64 * w + lane; if (e < 465) rpt[e] = rpb[h * 465 + e]; }
        bf16x8_t Qf[4];
        {
            gcb qp = PA + (tokb + r * 64 + c0 + m) * DHALF + h * DH + 8 * g;
            v4u qr[4]; float ss = 0.f;
#pragma unroll
            for (int ks = 0; ks < 4; ++ks) { qr[ks] = *(const GAS v4u*)(qp + 32 * ks); ss += sumsq8(qr[ks]); }
            ss = pg8::sum_rows4(ss);
            const float rq = rsqrtf(ss * (1.f / DH) + EPS) * 0.08838834764831845f;
#pragma unroll
            for (int ks = 0; ks < 4; ++ks) {
                const f32x4 ga = *(const LAS f32x4*)(F.lds + AT_GN + 4 * (32 * ks + 8 * g)), gb_ = *(const LAS f32x4*)(F.lds + AT_GN + 4 * (32 * ks + 8 * g + 4));
                const v4u v = qr[ks]; v4u o;
                o.x = pk2(bflo(v.x) * rq * ga.x, bfhi(v.x) * rq * ga.y); o.y = pk2(bflo(v.y) * rq * ga.z, bfhi(v.y) * rq * ga.w);
                o.z = pk2(bflo(v.z) * rq * gb_.x, bfhi(v.z) * rq * gb_.y); o.w = pk2(bflo(v.w) * rq * gb_.z, bfhi(v.w) * rq * gb_.w);
                Qf[ks] = __builtin_bit_cast(bf16x8_t, o);
            }
        }
        f32x4 S[16];
#define AT_KSTEP(j, i) do { const LAS unsigned char* kb_ = F.lds + AT_RING + (j) * 16384; bf16x8_t kf_[2][4]; \
            _Pragma("unroll") for (int hf = 0; hf < 2; ++hf) { const int rho = kc0 + 16 * hf + m; \
                _Pragma("unroll") for (int ks = 0; ks < 4; ++ks) kf_[hf][ks] = *(const LAS bf16x8_t*)(kb_ + 256 * rho + 16 * ((4 * ks + g) ^ (rho & 15))); } \
            __builtin_amdgcn_sched_barrier(0);                                \
            _Pragma("unroll") for (int hf = 0; hf < 2; ++hf) { f32x4 a = pg8::zero4(); \
                _Pragma("unroll") for (int ks = 0; ks < 4; ++ks) a = __builtin_amdgcn_mfma_f32_16x16x32_bf16(kf_[hf][ks], Qf[ks], a, 0, 0, 0); \
                S[2 * (i) + hf] = a; } } while (0)
#define AT_KITER(j) do { AT_WAIT(14); AT_BAR(); if ((j) >= 1) AT_ISSUE(baseU, offV, rs0, (j) - 1); \
            if (ro == 0) { if ((j) < 8) AT_KSTEP(j, ((j) < 8 ? (j) : 0)); } else { if ((j) >= 1) AT_KSTEP(j, ((j) >= 1 ? (j) - 1 : 0)); } } while (0)
        AT_KITER(0); AT_KITER(1); AT_KITER(2); AT_KITER(3); AT_KITER(4); AT_KITER(5); AT_KITER(6); AT_KITER(7); AT_KITER(8);
#undef AT_KSTEP
#undef AT_KITER
        const int qc = c0 + m, cs = min(max(qc - 8, 0), 48);
        float mx = -3.0e38f;
#pragma unroll
        for (int half = 0; half < 8; ++half) {
            float bv[2][4];
#pragma unroll
            for (int t8 = 0; t8 < 2; ++t8) { const int T = 2 * half + t8; const int dr = rs + (T >> 1) - r + 7; const LAS float* bp = rpt + dr * 31 + 15 - qc;
#pragma unroll
                for (int rr = 0; rr < 4; ++rr) { const int kcol = kc0 + 16 * (T & 1) + 4 * g + rr; const bool ok = (kcol >= cs) && (kcol < cs + 16); bv[t8][rr] = bp[ok ? kcol : qc]; } }
#pragma unroll
            for (int t8 = 0; t8 < 2; ++t8) asm volatile("" : "+v"(bv[t8][0]), "+v"(bv[t8][1]), "+v"(bv[t8][2]), "+v"(bv[t8][3]));
#pragma unroll
            for (int t8 = 0; t8 < 2; ++t8) { const int T = 2 * half + t8;
                const f32x4 rk4 = *(const LAS f32x4*)(rkw + 64 * (T >> 1) + 16 * (T & 1));
#pragma unroll
                for (int rr = 0; rr < 4; ++rr) {
                    const int kcol = kc0 + 16 * (T & 1) + 4 * g + rr;
                    const bool ok = (kcol >= cs) && (kcol < cs + 16);
                    const float sv = ok ? S[T][rr] * rk4[rr] + bv[t8][rr] : -3.0e38f;
                    S[T][rr] = sv; mx = fmaxf(mx, sv);
                } }
        }
        mx = pg8::max_rows4(mx);
        float sum = 0.f;
#pragma unroll
        for (int T = 0; T < 16; ++T)
#pragma unroll
            for (int rr = 0; rr < 4; ++rr) { const float p = (S[T][rr] > -1.0e38f) ? __expf(S[T][rr] - mx) : 0.f; S[T][rr] = p; sum += p; }
        sum = pg8::sum_rows4(sum);
        const float inv = 1.f / sum;
        bf16x8_t Pf[8];
#pragma unroll
        for (int i = 0; i < 8; ++i) { v4u o; o.x = pk2(S[2 * i][0], S[2 * i][1]); o.y = pk2(S[2 * i][2], S[2 * i][3]); o.z = pk2(S[2 * i + 1][0], S[2 * i + 1][1]); o.w = pk2(S[2 * i + 1][2], S[2 * i + 1][3]);
            Pf[i] = __builtin_bit_cast(bf16x8_t, o); }
        const unsigned ldsb = (unsigned)(uintptr_t)F.lds, vE = img_off<16>(kc0 + 4 * g + lq, (lp >> 1)) + 8 * (lp & 1), vO = vE ^ 32u;
        AtUnit Un = U; if (has_next) Un = at_unit(AT_WU(k + 1));
        gcb baseN = AT_BASE(Un);
        f32x4 O[8];
#pragma unroll
        for (int dt = 0; dt < 8; ++dt) O[dt] = pg8::zero4();
#define AT_TR(dst, addr, off) asm volatile("ds_read_b64_tr_b16 %0, %1 offset:%2" : "=v"(dst) : "v"(addr), "n"(off))
#define AT_VSTEP(j, i) do { const unsigned aE_ = ldsb + vE + (unsigned)(AT_RING + (j) * 16384), aO_ = ldsb + vO + (unsigned)(AT_RING + (j) * 16384); s16x4_t tq_[16]; \
            AT_TR(tq_[0], aE_, 0); AT_TR(tq_[1], aE_, 4096); AT_TR(tq_[2], aO_, 0); AT_TR(tq_[3], aO_, 4096); \
            AT_TR(tq_[4], aE_, 512); AT_TR(tq_[5], aE_, 4608); AT_TR(tq_[6], aO_, 512); AT_TR(tq_[7], aO_, 4608); \
            AT_TR(tq_[8], aE_, 1024); AT_TR(tq_[9], aE_, 5120); AT_TR(tq_[10], aO_, 1024); AT_TR(tq_[11], aO_, 5120); \
            AT_TR(tq_[12], aE_, 1536); AT_TR(tq_[13], aE_, 5632); AT_TR(tq_[14], aO_, 1536); AT_TR(tq_[15], aO_, 5632); \
            asm volatile("s_waitcnt lgkmcnt(0)" : "+v"(tq_[0]), "+v"(tq_[1]), "+v"(tq_[2]), "+v"(tq_[3]), "+v"(tq_[4]), "+v"(tq_[5]), "+v"(tq_[6]), "+v"(tq_[7]), \
                         "+v"(tq_[8]), "+v"(tq_[9]), "+v"(tq_[10]), "+v"(tq_[11]), "+v"(tq_[12]), "+v"(tq_[13]), "+v"(tq_[14]), "+v"(tq_[15])); \
            _Pragma("unroll") for (int dt = 0; dt < 8; ++dt) { \
                const bf16x8_t Vf = __builtin_shufflevector(tq_[2 * dt], tq_[2 * dt + 1], 0, 1, 2, 3, 4, 5, 6, 7); \
                O[dt] = __builtin_amdgcn_mfma_f32_16x16x32_bf16(Vf, Pf[i], O[dt], 0, 0, 0); } } while (0)
#define AT_VCOMP(j) do { if (ro == 0) { if ((j) < 8) AT_VSTEP(j, ((j) < 8 ? (j) : 0)); } else { if ((j) >= 1) AT_VSTEP(j, ((j) >= 1 ? (j) - 1 : 0)); } } while (0)
        if (has_next) {
#define AT_VITER(j) do { AT_WAIT(14); AT_BAR(); if ((j) == 0) AT_ISSUE(baseU, offV, rs0, 8); else AT_ISSUE(baseN, offK, Un.rs0, (j) - 1); AT_VCOMP(j); } while (0)
            AT_VITER(0); AT_VITER(1); AT_VITER(2); AT_VITER(3); AT_VITER(4); AT_VITER(5); AT_VITER(6); AT_VITER(7); AT_VITER(8);
#undef AT_VITER
        } else {
#define AT_VITER(j, n) do { AT_WAIT(n); AT_BAR(); if ((j) == 0) AT_ISSUE(baseU, offV, rs0, 8); AT_VCOMP(j); } while (0)
            AT_VITER(0, 14); AT_VITER(1, 14); AT_VITER(2, 12); AT_VITER(3, 10); AT_VITER(4, 8); AT_VITER(5, 6); AT_VITER(6, 4); AT_VITER(7, 2); AT_VITER(8, 0);
#undef AT_VITER
        }
#undef AT_VSTEP
#undef AT_TR
#undef AT_VCOMP
        gb op = O_ + (tokb + r * 64 + c0 + m) * ldo + h * DH + 4 * g;
#pragma unroll
        for (int dt = 0; dt < 8; ++dt) { const f32x4 o = O[dt] * inv; *(GAS v2u*)(op + 16 * dt) = (v2u){pk2(o.x, o.y), pk2(o.z, o.w)}; }
        if (has_next) {
            AT_BAR();
            AT_ISSUE(baseN, offK, Un.rs0, 8);
        }
    }
#undef AT_ISSUE
#undef AT_OFFS
#undef AT_BASE
#undef AT_WU
}
#undef AT_WAIT
#undef AT_BAR
constexpr int GM_W_OFF = 65536, GM_WRS = 288;
struct GateRegs { v4u v[8]; f32x4 p0, p1; };
__device__ __forceinline__ void gate_load(GateRegs& R, gcb ZZ, gcf RVS, int unit, int tid) {
    const int n = unit >> 3, gch = unit & 7, tok0 = n * 128;
#pragma unroll
    for (int x = 0; x < 8; ++x) { const int e = tid + NTHR * x, row = e >> 5, ch = e & 31; R.v[x] = *(const GAS v4u*)(ZZ + (size_t)(tok0 + row) * DC2 + DM + gch * 256 + 8 * ch); }
    gcf pp = RVS + (size_t)(tok0 + (tid >> 2)) * 32 + 8 * (tid & 3);
    R.p0 = *(const GAS f32x4*)pp; R.p1 = *(const GAS f32x4*)(pp + 4);
}
__device__ __forceinline__ void gate_rv(const GateRegs& R, LAS float* rvl, int tid) {
    float sacc = ((R.p0[0] + R.p0[1]) + (R.p0[2] + R.p0[3])) + ((R.p1[0] + R.p1[1]) + (R.p1[2] + R.p1[3]));
    sacc += swz_xor<1>(sacc); sacc += swz_xor<2>(sacc);
    if ((tid & 3) == 0) rvl[tid >> 2] = rsqrtf(sacc * (1.f / DM) + EPS);
}
__device__ __forceinline__ unsigned scale2(unsigned w, float r) { return pk2(bflo(w) * r, bfhi(w) * r); }
__device__ __forceinline__ void gmlp_gate_mfma(Frame& F, gb ZZ, gcf vgain, gcf ws_, gcf bs_) {
    const int w = F.wave;
    LAS float* rvl = (LAS float*)(F.lds + GM_W_OFF + 128 * GM_WRS);
    const int NU = (M / 128) * 8;
    if ((F.G & 7) != 0) return;
    const int gch = F.bx & 7;
    int unit = F.bx;
    GateRegs R;
    if (unit < NU) gate_load(R, ZZ, F.RVS, unit, F.tid);
    __syncthreads();
    for (int e = F.tid; e < 128 * 16; e += NTHR) { const int p = e >> 4, q8 = e & 15; gcf wp = ws_ + (size_t)gch * 16384 + p * 128 + 8 * q8;
        const f32x4 a = *(const GAS f32x4*)wp, bq = *(const GAS f32x4*)(wp + 4);
        *(LAS v4u*)(F.lds + GM_W_OFF + p * GM_WRS + 16 * q8) = (v4u){pk2(a.x, a.y), pk2(a.z, a.w), pk2(bq.x, bq.y), pk2(bq.z, bq.w)}; }
    if (unit < NU) gate_rv(R, rvl, F.tid);
    int par = 0;
    for (; unit < NU; unit += F.G, par ^= 1) {
        const int tok0 = (unit >> 3) * 128;
        int lane_ = F.lane; asm volatile("" : "+v"(lane_));
        const int m = lane_ & 15, g4 = lane_ >> 4, lq = m >> 2, lp = lane_ & 3;
        __syncthreads();
#pragma unroll
        for (int x = 0; x < 8; ++x) { const int e = F.tid + NTHR * x; const float r = rvl[par * 128 + (e >> 5)]; const v4u v = R.v[x];
            *(LAS v4u*)(F.lds + img_off<32>(e >> 5, e & 31)) = (v4u){scale2(v.x, r), scale2(v.y, r), scale2(v.z, r), scale2(v.w, r)}; }
        if (unit + F.G < NU) gate_load(R, ZZ, F.RVS, unit + F.G, F.tid);
        __syncthreads();
        f32x4 acc[8][2];
#pragma unroll
        for (int mt = 0; mt < 8; ++mt) { acc[mt][0] = pg8::zero4(); acc[mt][1] = pg8::zero4(); }
#pragma unroll
        for (int ks = 0; ks < 4; ++ks) {
            bf16x8_t Vf[2];
#pragma unroll
            for (int jj = 0; jj < 2; ++jj) { const int ct = 2 * w + jj;
                const s16x4_t t0 = ds_tr(F.lds + img_off<32>(32 * ks + 8 * g4 + lq, 2 * ct + (lp >> 1)) + 8 * (lp & 1));
                const s16x4_t t1 = ds_tr(F.lds + img_off<32>(32 * ks + 8 * g4 + 4 + lq, 2 * ct + (lp >> 1)) + 8 * (lp & 1));
                Vf[jj] = __builtin_shufflevector(t0, t1, 0, 1, 2, 3, 4, 5, 6, 7); }
#pragma unroll
            for (int mt = 0; mt < 8; ++mt) { const bf16x8_t Wf = *(const LAS bf16x8_t*)(F.lds + GM_W_OFF + (16 * mt + m) * GM_WRS + 64 * ks + 16 * g4);
                acc[mt][0] = __builtin_amdgcn_mfma_f32_16x16x32_bf16(Vf[0], Wf, acc[mt][0], 0, 0, 0);
                acc[mt][1] = __builtin_amdgcn_mfma_f32_16x16x32_bf16(Vf[1], Wf, acc[mt][1], 0, 0, 0); }
        }
        if (unit + F.G < NU) gate_rv(R, rvl + (par ^ 1) * 128, F.tid);
        const int colb = gch * 256 + 32 * w + 4 * g4;
        const f32x4 gn0 = *(const GAS f32x4*)(vgain + colb), gn1 = *(const GAS f32x4*)(vgain + colb + 16);
        gb ub = ZZ + (size_t)(tok0 + m) * DC2 + colb;
        float bsq[8]; v2u uq[8][2];
#pragma unroll
        for (int mt = 0; mt < 8; ++mt) { bsq[mt] = bs_[gch * 128 + 16 * mt + m];
#pragma unroll
            for (int jj = 0; jj < 2; ++jj) uq[mt][jj] = *(const GAS v2u*)(ub + (size_t)(16 * mt) * DC2 + 16 * jj); }
#pragma unroll
        for (int mt = 0; mt < 8; ++mt) { asm volatile("" : "+v"(bsq[mt]));
#pragma unroll
            for (int jj = 0; jj < 2; ++jj) asm volatile("" : "+v"(uq[mt][jj])); }
#pragma unroll
        for (int mt = 0; mt < 8; ++mt) { const float bsp = bsq[mt];
#pragma unroll
            for (int jj = 0; jj < 2; ++jj) { const f32x4 gn = jj ? gn1 : gn0; const f32x4 sv = acc[mt][jj] * gn + bsp;
                const v2u uu = uq[mt][jj];
                *(GAS v2u*)(ub + (size_t)(16 * mt) * DC2 + 16 * jj) = (v2u){pk2(bflo(uu.x) * sv.x, bfhi(uu.x) * sv.y), pk2(bflo(uu.y) * sv.z, bfhi(uu.y) * sv.w)}; } }
    }
}

__device__ __forceinline__ void make_frame(Frame& F, const Params*& kp, int wbase) {
    const Params* k = (const Params*)__builtin_amdgcn_kernarg_segment_ptr();
    asm volatile("" : "+s"(k));
    kp = k;
    const int t_ = wbase + pg8::lane_id_asm();
    extern __shared__ __attribute__((aligned(16))) unsigned char lds_raw[];
    F.lds = (LAS unsigned char*)lds_raw;
    F.MISC = (volatile LAS unsigned*)(F.lds + MISC_OFF);
    F.tid = t_; F.lane = t_ & 63; { int wv = wbase >> 6; asm volatile("" : "+s"(wv)); F.wave = wv; } F.wbase = wbase;
    F.G = gridDim.x; { int bx = blockIdx.x; asm volatile("" : "+s"(bx)); F.bx = bx; F.vcu = (F.G % 8 == 0) ? (bx % 8) * (F.G / 8) + bx / 8 : bx; }
    GAS unsigned char* ws = (GAS unsigned char*)k->ws; F.ws = ws;
    F.ctl = (gu32*)(ws + WS_CTL);
    F.xp = (gcf)k->in[0]; F.xs = (gcf)k->in[1]; F.out = (gf)k->out;
    F.W1 = (gb)(ws + WS_W1); F.W2 = (gb)(ws + WS_W2); F.XB = (gb)(ws + WS_XB);
    F.FILT = (gf)(ws + WS_FILT); F.SSA = (gb)(ws + WS_SSA); F.SSB = (gb)(ws + WS_SSB); F.RVS = (gf)(ws + WS_RVS); F.INVS = (gf)(ws + WS_INVS); F.RVF = (gb)(ws + WS_RVF);
}
__device__ __forceinline__ void grid_bar() {
    const Params* k = (const Params*)__builtin_amdgcn_kernarg_segment_ptr();
    asm volatile("" : "+s"(k));
    extern __shared__ __attribute__((aligned(16))) unsigned char lds_raw[];
    XcdBarrier b; b.bar = (unsigned*)(k->ws + WS_CTL) + CW_BAR; b.x = xb_xcc_id(); b.st = (volatile LAS unsigned*)((LAS unsigned char*)lds_raw + MISC_OFF) + 8;
    xcd_barrier(b);
}
constexpr int NPHASES = 25;
__global__ void __launch_bounds__(NTHR, 2) fwd_kernel(Params P) {
    extern __shared__ __attribute__((aligned(16))) unsigned char lds_raw[];
    {
        volatile LAS unsigned* MISC = (volatile LAS unsigned*)((LAS unsigned char*)lds_raw + MISC_OFF);
        if (threadIdx.x < 32) MISC[threadIdx.x] = 0u;
        __syncthreads();
    }
    const int lo = P.ph_lo, hi = P.ph_hi;
    const int wbase = __builtin_amdgcn_readfirstlane(threadIdx.x);
    if (hi - lo > 1) (void)xcd_barrier_post((unsigned*)(P.ws + WS_CTL) + CW_BAR, (volatile LAS unsigned*)((LAS unsigned char*)lds_raw + MISC_OFF) + 8);
    int ph = 0;
#define PH_BEGIN if (ph >= lo && ph < hi) { Frame F; const Params* kp; make_frame(F, kp, wbase); \
    const gb BIG = (gb)(F.ws + WS_BIG); const gb PA = (gb)(F.ws + WS_BIG + BIG_PA); const gb PB = (gb)(F.ws + WS_BIG + BIG_PB); \
    const gb UT = (gb)(F.ws + WS_BIG + BIG_UT); const gb X0T = (gb)(F.ws + WS_BIG + BIG_X0T); const gb GT = PB; \
    const gb WINc = (gb)(F.ws + ((layer & 1) ? WS_WIN2 : WS_WIN)); const gb WOUTc = (gb)(F.ws + ((layer & 1) ? WS_WOUT2 : WS_WOUT)); \
    (void)BIG; (void)PA; (void)PB; (void)UT; (void)X0T; (void)GT; (void)WINc; (void)WOUTc;
#define PH_END if (ph + 1 < hi) grid_bar(); } ++ph;
#define LAYER_CHORES() do { \
        gcf nmix = ((gcf)kp->in[2]) + (layer + 1) * DM; gcf nmlp = ((gcf)kp->in[3]) + layer * DM; \
        gcf w1f = ((gcf)kp->in[25]) + (size_t)layer * DM * DFF; gcf w2f = ((gcf)kp->in[26]) + (size_t)layer * DFF * DM; \
        if (layer == 0) { const CvtJob jobs[2] = { {((gcf)kp->in[20]), nmix, (gb)(F.ws + WS_WIN2), DM, DC2}, {((gcf)kp->in[24]), nullptr, (gb)(F.ws + WS_WOUT2), DM, DM} }; convert_jobs<2>(F, jobs, 0); } \
        else if (layer == 1) { const CvtJob jobs[4] = { {((gcf)kp->in[4]) + (size_t)DM * DINAB, nmix, (gb)(F.ws + WS_WIN), DM, DINAB}, {((gcf)kp->in[19]) + (size_t)DM * DM, nullptr, (gb)(F.ws + WS_WOUT), DM, DM}, \
                                                         {w1f, nmlp, F.W1, DM, DFF}, {w2f, nullptr, F.W2, DFF, DM} }; convert_jobs<4>(F, jobs, 0); } \
        else if (layer == 2) { const CvtJob jobs[4] = { {((gcf)kp->in[20]) + (size_t)DM * DC2, nmix, (gb)(F.ws + WS_WIN2), DM, DC2}, {((gcf)kp->in[24]) + (size_t)DM * DM, nullptr, (gb)(F.ws + WS_WOUT2), DM, DM}, \
                                                         {w1f, nmlp, F.W1, DM, DFF}, {w2f, nullptr, F.W2, DFF, DM} }; convert_jobs<4>(F, jobs, 0); } \
        else { const CvtJob jobs[2] = { {w1f, nmlp, F.W1, DM, DFF}, {w2f, nullptr, F.W2, DFF, DM} }; convert_jobs<2>(F, jobs, 0); } \
    } while (0)

    {
        const int layer = 0;
        PH_BEGIN
              xb_rows(F);
            const CvtJob jobs[4] = { {((gcf)kp->in[4]), ((gcf)kp->in[2]), WINc, DM, DINAB}, {((gcf)kp->in[19]), nullptr, WOUTc, DM, DM}, {((gcf)kp->in[25]), ((gcf)kp->in[3]), F.W1, DM, DFF}, {((gcf)kp->in[26]), nullptr, F.W2, DFF, DM} };
              convert_jobs<4>(F, jobs, 0);
            filter_gen(F, ((gcf)kp->in[10]), ((gcf)kp->in[11]), ((gcf)kp->in[12]), ((gcf)kp->in[13]), ((gcf)kp->in[14]), ((gcf)kp->in[15]), ((gcf)kp->in[16]), ((gcf)kp->in[17]));
        PH_END
    }
    for (int layer = 0; layer < 4; ++layer) {
        const int j = layer >> 1;
        if ((layer & 1) == 0) {
            PH_BEGIN
                pg8::Gemm g{(const bf16*)F.XB, (const bf16*)WINc, M, DINAB, DM, DM, F.wbase}; pg8::StaticOrder S; S.init(M, DINAB, F.G, F.bx);
                pg8::EpiBf16<0, false, true> E{PA, DHALF, DHALF, (size_t)(PB - PA), F.SSA, F.RVS, 0, F.lds + RING_BYTES};
                pg8::gemm_phase<pg8::EpiBf16<0, false, true>, pg8::StaticOrder, true, true>(F.lds, g, S, E);
            PH_END
            PH_BEGIN
                  hyena_prep(F, PB, UT, X0T, ((gcf)kp->in[5]) + j * 3 * DHALF, ((gcf)kp->in[6]) + j * DHALF);
                filter_norm(F);
                __syncthreads();
                  LAYER_CHORES();
                __syncthreads();
                make_frame(F, kp, wbase);
                  attn_coop(F, (gcb)(F.ws + WS_BIG + BIG_PA), (gb)(F.ws + WS_BIG + BIG_PA), DHALF, ((gcf)kp->in[7]) + j * DH, ((gcf)kp->in[8]) + j * DH, ((gcf)kp->in[9]) + j * HA * 15 * 31, F.RVS);
            PH_END
            PH_BEGIN
                hyena_conv_mfma(F, UT, X0T, GT, ((gcf)kp->in[18]) + j * DB);
            PH_END
            PH_BEGIN
                hyena_post(F, GT, PA + DA, DHALF);
            PH_END
            PH_BEGIN
                pg8::Gemm g{(const bf16*)PA, (const bf16*)WOUTc, M, DM, DM, DHALF, F.wbase}; pg8::StaticOrder S; S.init(M, DM, F.G, F.bx);
                { pg8::EpiRes<1> E{nullptr, nullptr, 0, F.out, DM, F.XB, F.SSB};
                    pg8::gemm_phase<pg8::EpiRes<1>, pg8::StaticOrder, true, true>(F.lds, g, S, E); }
            PH_END
        } else {
            PH_BEGIN
                pg8::Gemm g{(const bf16*)F.XB, (const bf16*)WINc, M, DC2, DM, DM, F.wbase}; pg8::StaticOrder S; S.init(M, DC2, F.G, F.bx);
                pg8::EpiBf16<1, true> E{BIG, DC2, 0, 0, F.SSA, F.RVS, 8, F.lds + RING_BYTES};
                pg8::gemm_phase<pg8::EpiBf16<1, true>, pg8::StaticOrder, true, true>(F.lds, g, S, E);
            PH_END
            PH_BEGIN
                  gmlp_gate_mfma(F, BIG, ((gcf)kp->in[21]) + j * DM, ((gcf)kp->in[22]) + (size_t)j * 8 * 128 * 128, ((gcf)kp->in[23]) + j * 8 * 128);
                __syncthreads();
                  LAYER_CHORES();
                  if (layer == 1) filter_gen(F, ((gcf)kp->in[10]) + EMB * FO, ((gcf)kp->in[11]) + FO, ((gcf)kp->in[12]) + FO * FO, ((gcf)kp->in[13]) + FO, ((gcf)kp->in[14]) + FO * FO, ((gcf)kp->in[15]) + FO, ((gcf)kp->in[16]) + (size_t)FO * 2 * DB, ((gcf)kp->in[17]) + FO);
            PH_END
            PH_BEGIN
                pg8::Gemm g{(const bf16*)BIG, (const bf16*)WOUTc, M, DM, DM, DC2, F.wbase}; pg8::StaticOrder S; S.init(M, DM, F.G, F.bx);
                pg8::EpiRes<1> E{nullptr, nullptr, 0, F.out, DM, F.XB, F.SSB};
                pg8::gemm_phase<pg8::EpiRes<1>, pg8::StaticOrder, true, true>(F.lds, g, S, E);
            PH_END
        }
        PH_BEGIN
            pg8::Gemm g{(const bf16*)F.XB, (const bf16*)F.W1, M, DFF, DM, DM, F.wbase}; pg8::StaticOrder S; S.init(M, DFF, F.G, F.bx);
            pg8::EpiBf16<2, false> E{BIG, DFF, 0, 0, F.SSB, nullptr, 0, F.lds + RING_BYTES};
            pg8::gemm_phase<pg8::EpiBf16<2, false>, pg8::StaticOrder, true, true>(F.lds, g, S, E);
        PH_END
        PH_BEGIN
            pg8::Gemm g{(const bf16*)BIG, (const bf16*)F.W2, M, DM, DFF, DFF, F.wbase}; pg8::StaticOrder S; S.init(M, DM, F.G, F.bx);
            if (layer < 3) { pg8::EpiRes<1> E{nullptr, nullptr, 0, F.out, DM, F.XB, F.SSA};
                pg8::gemm_phase<pg8::EpiRes<1>, pg8::StaticOrder, true, true>(F.lds, g, S, E); }
            else { pg8::EpiRes<2> E{nullptr, nullptr, 0, F.out, DM, F.XB, F.SSA};
                pg8::gemm_phase<pg8::EpiRes<2>, pg8::StaticOrder, true, true>(F.lds, g, S, E); }
        PH_END
    }
#undef PH_BEGIN
#undef PH_END
#undef LAYER_CHORES
}

#ifndef MK_ONE_LAUNCH
#define MK_ONE_LAUNCH 1
#endif
extern "C" void kernel_launch(void* const* d_in, const int* in_sizes, int n_in, void* d_out, int out_size, void* d_ws, size_t ws_size, hipStream_t stream) {
    static int grid = 0;
    if (grid == 0) {
        if (n_in != 27 || out_size != M * DM || ws_size < WS_END) { fprintf(stderr, "kernel_launch: unexpected shapes (n_in %d out %d ws %zu)\n", n_in, out_size, ws_size); grid = -1; return; }
        int dev = 0, cus = 0;
        if (hipGetDevice(&dev) != hipSuccess || hipDeviceGetAttribute(&cus, hipDeviceAttributeMultiprocessorCount, dev) != hipSuccess) { grid = -1; return; }
        if (hipFuncSetAttribute((const void*)fwd_kernel, hipFuncAttributeMaxDynamicSharedMemorySize, LDS_BYTES) != hipSuccess) { fprintf(stderr, "kernel_launch: hipFuncSetAttribute failed\n"); grid = -1; return; }
        (void)hipGetLastError();
        grid = cus;
    }
    if (grid < 0) return;
    (void)hipMemsetAsync((char*)d_ws + WS_CTL, 0, CTL_ZERO_BYTES, stream);
    Params p{};
    for (int i = 0; i < 27; ++i) p.in[i] = (const float*)d_in[i];
    p.out = (float*)d_out; p.ws = (unsigned char*)d_ws;
#if MK_ONE_LAUNCH
    p.ph_lo = 0; p.ph_hi = NPHASES;
    hipLaunchKernelGGL(fwd_kernel, dim3(grid), dim3(NTHR), LDS_BYTES, stream, p);
#else
    for (int ph = 0; ph < NPHASES; ++ph) { p.ph_lo = ph; p.ph_hi = ph + 1; hipLaunchKernelGGL(fwd_kernel, dim3(grid), dim3(NTHR), LDS_BYTES, stream, p); }
#endif
}
```

```cpp
#include <hip/hip_runtime.h>
#include <cstdio>
#include <cstdint>
#include <cmath>
namespace pg8 {
#define PG8_LAS __attribute__((address_space(3)))
typedef unsigned short bf16_t;
typedef short bf16x8 __attribute__((ext_vector_type(8)));
typedef float f32x4 __attribute__((ext_vector_type(4)));
typedef unsigned u32x4 __attribute__((ext_vector_type(4)));
constexpr int BM = 256, BK = 64, HALF = 128, HTB = HALF * BK * 2  , STAGE_BYTES = 8 * HTB, NXCD = 8, WGM = 8;

__host__ __device__ __forceinline__ int lds_byte(int r, int c) { const int st = (r >> 4) * 2 + (c >> 5), rr = r & 15, cc = c & 31, ob = rr * 64 + cc * 2; return st * 1024 + (ob ^ (((ob >> 9) & 1) << 5)); }
__host__ __device__ __forceinline__ void stage_rc(int b, int& R, int& C) { const int st = b / 1024, sb = b % 1024, swz = sb ^ (((sb >> 9) & 1) << 5); R = (st >> 1) * 16 + swz / 64; C = (st & 1) * 32 + (swz % 64) / 2; }
__host__ __device__ __forceinline__ int perm32(int rho) { const int n = rho >> 4, i = rho & 15; return 8 * (i >> 2) + 4 * n + (i & 3); }

struct Unit { int pm, pn; };
struct Gemm { const bf16_t* A; const bf16_t* Bt; int M, N, K, lda, wbase; };
__device__ __forceinline__ int lane_id_asm() { int l; asm volatile("v_mbcnt_lo_u32_b32 %0, -1, 0\n\tv_mbcnt_hi_u32_b32 %0, -1, %0" : "=v"(l)); return l; }

struct StaticOrder {
    int nM, nN, nwg, G, c;
    __host__ __device__ void init(int M, int N, int G_, int c_) { nM = M / BM; nN = N / BM; nwg = nM * nN; G = G_; c = c_; }
    __host__ __device__ bool next(int i, Unit& u) const {
        const long L = (long)i * G + c; if (L >= nwg) return false;
        int wgid = (int)L; { const int q = nwg / NXCD, r = nwg % NXCD, xcd = wgid % NXCD, off = wgid / NXCD; wgid = (xcd < r ? xcd * (q + 1) : r * (q + 1) + (xcd - r) * q) + off; }
        const int nig = WGM * nN, gid = wgid / nig, fm = gid * WGM, gsz = (nM - fm) < WGM ? (nM - fm) : WGM;
        u.pm = fm + ((wgid % nig) % gsz); u.pn = (wgid % nig) / gsz; return true;
    }
    __device__ __forceinline__ void a_ready(const Unit&) const {}
    __device__ __forceinline__ void done(const Unit&) const {}
};

#define PG8_GAS __attribute__((address_space(1)))
__device__ __forceinline__ unsigned cvt_pk_bf16(float lo, float hi) { unsigned r; asm volatile("v_cvt_pk_bf16_f32 %0, %1, %2" : "=v"(r) : "v"(lo), "v"(hi)); return r; }
__device__ __forceinline__ f32x4 zero4() { f32x4 z; asm volatile("v_mov_b32 %0, 0\n\tv_mov_b32 %1, 0\n\tv_mov_b32 %2, 0\n\tv_mov_b32 %3, 0" : "=v"(z[0]), "=v"(z[1]), "=v"(z[2]), "=v"(z[3])); return z; }
__device__ __forceinline__ float sum_rows4(float v) {
    unsigned u = __builtin_bit_cast(unsigned, v);
    const auto r = __builtin_amdgcn_permlane16_swap(u, u, false, false);
    const float s = __builtin_bit_cast(float, (unsigned)r[0]) + __builtin_bit_cast(float, (unsigned)r[1]);
    u = __builtin_bit_cast(unsigned, s);
    const auto q = __builtin_amdgcn_permlane32_swap(u, u, false, false);
    return __builtin_bit_cast(float, (unsigned)q[0]) + __builtin_bit_cast(float, (unsigned)q[1]);
}
__device__ __forceinline__ float max_rows4(float v) {
    unsigned u = __builtin_bit_cast(unsigned, v);
    const auto r = __builtin_amdgcn_permlane16_swap(u, u, false, false);
    const float s = fmaxf(__builtin_bit_cast(float, (unsigned)r[0]), __builtin_bit_cast(float, (unsigned)r[1]));
    u = __builtin_bit_cast(unsigned, s);
    const auto q = __builtin_amdgcn_permlane32_swap(u, u, false, false);
    return fmaxf(__builtin_bit_cast(float, (unsigned)q[0]), __builtin_bit_cast(float, (unsigned)q[1]));
}
__device__ __forceinline__ void add_f32_ret(float* p, float v) { const float old = __hip_atomic_fetch_add(p, v, __ATOMIC_RELAXED, __HIP_MEMORY_SCOPE_AGENT); asm volatile("" :: "v"(old)); }
__device__ __forceinline__ float gelu_tanh(float x) {
    const float a2 = 1.5957691216f * x * (1.0f + 0.044715f * x * x);
    const float e = __builtin_amdgcn_exp2f(-1.4426950408889634f * a2);
    return x * __builtin_amdgcn_rcpf(1.0f + e);
}
template <int ACT> __device__ __forceinline__ float act_fn(float v) {
    if (ACT == 1) return gelu_tanh(v);
    if (ACT == 2) { const float r = v > 0.f ? v : 0.f; return r * r; }
    return v;
}
template <int ACT, bool RVS, bool KN = false> struct EpiBf16 {
    static constexpr bool PERM = true, AFTER_DRAIN = false;
    PG8_GAS bf16_t* O; int ldc; int split_cols; size_t split_stride; const PG8_GAS bf16_t* ps; PG8_GAS float* rvs; int rvs_pn0; PG8_LAS unsigned char* psl;
    __device__ __forceinline__ void pre(const Unit& u, int wid, int lane) const {
#pragma unroll
        for (int i = 0; i < 2; ++i) { const int j = 2 * wid + i;
            __builtin_amdgcn_global_load_lds((const PG8_GAS unsigned*)(ps + ((size_t)(u.pm * BM + 16 * j + (lane >> 2)) * 32 + 8 * (lane & 3))), (PG8_LAS unsigned*)(psl + 1024 * j), 16, 0, 0); }
    }
    __device__ __forceinline__ void operator()(const f32x4 (&acc)[2][2][4][2], const Unit& u, int wr, int wc, int fr, int fq) const {
        const int row0 = u.pm * BM + wr * 64 + fr; int colt = u.pn * BM; PG8_GAS bf16_t* base = O;
        if (split_cols) { const int t = colt / split_cols; base += (size_t)t * split_stride; colt -= t * split_cols; }
        const int col0 = colt + wc * 32 + 8 * fq;
        float rr[2][4];
#pragma unroll
        for (int ai = 0; ai < 2; ++ai)
#pragma unroll
            for (int m = 0; m < 4; ++m) { const u32x4 pv = *(const PG8_LAS u32x4*)(psl + (wr * 64 + fr + ai * HALF + m * 16) * 64 + 16 * fq);
                const float s8 = ((__builtin_bit_cast(float, pv.x << 16) + __builtin_bit_cast(float, pv.x & 0xffff0000u)) + (__builtin_bit_cast(float, pv.y << 16) + __builtin_bit_cast(float, pv.y & 0xffff0000u)))
                               + ((__builtin_bit_cast(float, pv.z << 16) + __builtin_bit_cast(float, pv.z & 0xffff0000u)) + (__builtin_bit_cast(float, pv.w << 16) + __builtin_bit_cast(float, pv.w & 0xffff0000u)));
                rr[ai][m] = __builtin_amdgcn_rsqf(sum_rows4(s8) * (1.0f / 2048.0f) + 1e-6f); }
        const bool do_rvs = RVS && (u.pn >= rvs_pn0);
#pragma unroll
        for (int ai = 0; ai < 2; ++ai)
#pragma unroll
            for (int m = 0; m < 4; ++m) { PG8_GAS bf16_t* rowp = base + (size_t)(row0 + ai * HALF + m * 16) * ldc + col0; const float r = rr[ai][m]; float sq = 0.f; float sk[2] = {0.f, 0.f};
#pragma unroll
                for (int bj = 0; bj < 2; ++bj) { const f32x4 v0 = acc[ai][bj][m][0] * r, v1 = acc[ai][bj][m][1] * r;
                    const float a0 = act_fn<ACT>(v0[0]), a1 = act_fn<ACT>(v0[1]), a2 = act_fn<ACT>(v0[2]), a3 = act_fn<ACT>(v0[3]);
                    const float a4 = act_fn<ACT>(v1[0]), a5 = act_fn<ACT>(v1[1]), a6 = act_fn<ACT>(v1[2]), a7 = act_fn<ACT>(v1[3]);
                    if (RVS) sq += ((a0 * a0 + a1 * a1) + (a2 * a2 + a3 * a3)) + ((a4 * a4 + a5 * a5) + (a6 * a6 + a7 * a7));
                    if (KN) sk[bj] = ((a0 * a0 + a1 * a1) + (a2 * a2 + a3 * a3)) + ((a4 * a4 + a5 * a5) + (a6 * a6 + a7 * a7));
                    u32x4 w; w.x = cvt_pk_bf16(a0, a1); w.y = cvt_pk_bf16(a2, a3); w.z = cvt_pk_bf16(a4, a5); w.w = cvt_pk_bf16(a6, a7);
                    *(PG8_GAS u32x4*)(rowp + bj * HALF) = w; }
                if (RVS) { sq = sum_rows4(sq);
                    if (do_rvs && fq == 0) rvs[(size_t)(row0 + ai * HALF + m * 16) * 32 + (u.pn - rvs_pn0) * 4 + wc] = sq; }
                if (KN) { if (u.pn >= 4 && u.pn < 8) { const float s0 = sum_rows4(sk[0]), s1 = sum_rows4(sk[1]);
                    if (fq == 0) { PG8_GAS float* kp = rvs + (size_t)(row0 + ai * HALF + m * 16) * 32 + (u.pn - 4) * 8 + wc; kp[0] = s0; kp[4] = s1; } } } }
    }
};
template <int MODE> struct EpiRes {
    static constexpr bool PERM = true, AFTER_DRAIN = false;
    const PG8_GAS float* base_lo; const PG8_GAS float* base_hi; int split_row; PG8_GAS float* out; int ldc; PG8_GAS bf16_t* xb; PG8_GAS bf16_t* ps;
    __device__ __forceinline__ void pre(const Unit&, int, int) const {}
    __device__ __forceinline__ void operator()(const f32x4 (&acc)[2][2][4][2], const Unit& u, int wr, int wc, int fr, int fq) const {
        const int row0 = u.pm * BM + wr * 64 + fr, col0 = u.pn * BM + wc * 32 + 8 * fq;
        const PG8_GAS float* bp = (u.pm * BM < split_row) ? base_lo : base_hi;
        u32x4 xv[2][4][2];
        if (MODE != 0) {
#pragma unroll
            for (int ai = 0; ai < 2; ++ai)
#pragma unroll
                for (int m = 0; m < 4; ++m)
#pragma unroll
                    for (int bj = 0; bj < 2; ++bj) xv[ai][m][bj] = *(const PG8_GAS u32x4*)(xb + (size_t)(row0 + ai * HALF + m * 16) * ldc + col0 + bj * HALF);
        }
#pragma unroll
        for (int ai = 0; ai < 2; ++ai)
#pragma unroll
            for (int m = 0; m < 4; ++m) { const size_t off = (size_t)(row0 + ai * HALF + m * 16) * ldc + col0; float sq = 0.f;
#pragma unroll
                for (int bj = 0; bj < 2; ++bj) {
                    f32x4 o0, o1;
                    if (MODE == 0) { o0 = *(const PG8_GAS f32x4*)(bp + off + bj * HALF); o1 = *(const PG8_GAS f32x4*)(bp + off + bj * HALF + 4); }
                    else { const u32x4 x4 = xv[ai][m][bj];
                        o0 = (f32x4){__builtin_bit_cast(float, x4.x << 16), __builtin_bit_cast(float, x4.x & 0xffff0000u), __builtin_bit_cast(float, x4.y << 16), __builtin_bit_cast(float, x4.y & 0xffff0000u)};
                        o1 = (f32x4){__builtin_bit_cast(float, x4.z << 16), __builtin_bit_cast(float, x4.z & 0xffff0000u), __builtin_bit_cast(float, x4.w << 16), __builtin_bit_cast(float, x4.w & 0xffff0000u)}; }
                    o0 += acc[ai][bj][m][0]; o1 += acc[ai][bj][m][1];
                    if (MODE == 2) { *(PG8_GAS f32x4*)(out + off + bj * HALF) = o0; *(PG8_GAS f32x4*)(out + off + bj * HALF + 4) = o1; }
                    else { sq += ((o0[0] * o0[0] + o0[1] * o0[1]) + (o0[2] * o0[2] + o0[3] * o0[3])) + ((o1[0] * o1[0] + o1[1] * o1[1]) + (o1[2] * o1[2] + o1[3] * o1[3]));
                        u32x4 w; w.x = cvt_pk_bf16(o0[0], o0[1]); w.y = cvt_pk_bf16(o0[2], o0[3]); w.z = cvt_pk_bf16(o1[0], o1[1]); w.w = cvt_pk_bf16(o1[2], o1[3]);
                        *(PG8_GAS u32x4*)(xb + off + bj * HALF) = w; } }
                if (MODE != 2) { sq = sum_rows4(sq); if (fq == 0) ps[(size_t)(row0 + ai * HALF + m * 16) * 32 + u.pn * 4 + wc] = (bf16_t)(cvt_pk_bf16(sq, 0.f) & 0xffffu); }
                if (MODE == 0 && (m & 1)) asm volatile("" ::: "memory"); }
    }
};

template <class Epi, class Sched, bool ALIGN_EPI = false, bool SP2 = false>
__device__ __forceinline__ void gemm_phase(PG8_LAS unsigned char* lds, const Gemm g, const Sched& S, const Epi& E) {
    const int tid = g.wbase + lane_id_asm(), wid = __builtin_amdgcn_readfirstlane(tid >> 6), lane = tid & 63, wr = wid >> 2, wc = wid & 3, fr = lane & 15, fq = lane >> 4;
    const int K = g.K, nt = K / BK, LDA = g.lda;
    unsigned voffA, voffB;
    { int R, C; stage_rc(tid * 16, R, C); const int Rb = Epi::PERM ? ((R & ~31) + perm32(R & 31)) : R;
      voffA = (unsigned)(R * LDA + C) * 2u; voffB = (unsigned)(Rb * K + C) * 2u; }
    const size_t s64voffA = (size_t)64 * LDA * 2, s64voffB = (size_t)64 * K * 2;
    const size_t kstep = (size_t)(BK * 2);
    const size_t hstep = (size_t)HALF * K * 2, hstepA = (size_t)HALF * LDA * 2;
    const size_t tstep = 2 * hstep, tstepA = 2 * hstepA;
    const unsigned ldsw = (unsigned)wid * 1024u;
    const int aoff = lds_byte(wr * 64 + fr, fq * 8), boff = lds_byte(wc * 32 + fr, fq * 8);
#define PG8_SA(b, h) (((b) * 2 + (h)) * HTB)
#define PG8_SB(b, h) ((4 + (b) * 2 + (h)) * HTB)
#define PG8_STAGE(bufoff, gbase, voff) do { _Pragma("unroll") for (int _i = 0; _i < 2; ++_i) \
        __builtin_amdgcn_global_load_lds((const unsigned*)((const char*)(gbase) + _i * s64##voff + (voff)), (PG8_LAS unsigned*)(lds + (bufoff) + ldsw + _i * 8192), 16, 0, 0); } while (0)
#define PG8_LDA(dst, b, h) do { _Pragma("unroll") for (int m = 0; m < 4; ++m) _Pragma("unroll") for (int k = 0; k < 2; ++k) dst[m][k] = *(const PG8_LAS bf16x8*)(lds + PG8_SA(b, h) + aoff + m * 2048 + k * 1024); } while (0)
#define PG8_LDB(dst, b, h) do { _Pragma("unroll") for (int n = 0; n < 2; ++n) _Pragma("unroll") for (int k = 0; k < 2; ++k) dst[n][k] = *(const PG8_LAS bf16x8*)(lds + PG8_SB(b, h) + boff + n * 2048 + k * 1024); } while (0)
#define PG8_MMA(ai, bj, At, Bt) do { __builtin_amdgcn_s_setprio(1); _Pragma("unroll") for (int m = 0; m < 4; ++m) _Pragma("unroll") for (int n = 0; n < 2; ++n) _Pragma("unroll") for (int k = 0; k < 2; ++k) \
        acc[ai][bj][m][n] = __builtin_amdgcn_mfma_f32_16x16x32_bf16(Bt[n][k], At[m][k], acc[ai][bj][m][n], 0, 0, 0); __builtin_amdgcn_s_setprio(0); } while (0)
#define PG8_WAIT_V(n) asm volatile("s_waitcnt vmcnt(" #n ")" ::: "memory")
#define PG8_WAIT_L(n) asm volatile("s_waitcnt lgkmcnt(" #n ")" ::: "memory")
#define PG8_BAR __builtin_amdgcn_s_barrier()
#define PG8_SCHED __builtin_amdgcn_sched_barrier(0)
    Unit cur, nxt; int ui = 0;
    if (!S.next(0, cur)) return;
    f32x4 acc[2][2][4][2];
#pragma unroll
    for (int a = 0; a < 2; ++a)
#pragma unroll
        for (int b = 0; b < 2; ++b)
#pragma unroll
            for (int m = 0; m < 4; ++m)
#pragma unroll
                for (int n = 0; n < 2; ++n) acc[a][b][m][n] = zero4();
    bf16x8 At[4][2], B0[2][2], B1[2][2];
    const char* cA = (const char*)g.A + (size_t)cur.pm * tstepA; const char* cB = (const char*)g.Bt + (size_t)cur.pn * tstep;
    S.a_ready(cur);
    if constexpr (SP2) {
        PG8_STAGE(PG8_SB(0, 0), cB, voffB); PG8_STAGE(PG8_SB(0, 1), cB + hstep, voffB); PG8_STAGE(PG8_SA(0, 0), cA, voffA); PG8_STAGE(PG8_SA(0, 1), cA + hstepA, voffA);
        if (wr == 1) PG8_BAR;
        PG8_WAIT_V(2); PG8_BAR;
        PG8_STAGE(PG8_SB(1, 0), cB + kstep, voffB); PG8_STAGE(PG8_SA(1, 0), cA + kstep, voffA); PG8_STAGE(PG8_SB(1, 1), cB + hstep + kstep, voffB);
        PG8_WAIT_V(6); PG8_BAR;
    } else {
        PG8_STAGE(PG8_SB(0, 0), cB, voffB); PG8_STAGE(PG8_SA(0, 0), cA, voffA); PG8_STAGE(PG8_SB(0, 1), cB + hstep, voffB); PG8_STAGE(PG8_SA(0, 1), cA + hstepA, voffA);
        if (wr == 1) PG8_BAR;
        PG8_WAIT_V(4); PG8_BAR;
        PG8_STAGE(PG8_SB(1, 0), cB + kstep, voffB); PG8_STAGE(PG8_SA(1, 0), cA + kstep, voffA); PG8_STAGE(PG8_SB(1, 1), cB + hstep + kstep, voffB);
        PG8_WAIT_V(6); PG8_BAR;
    }
    for (;;) {
        const bool has_next = S.next(ui + 1, nxt);
        const char* nA = has_next ? (const char*)g.A + (size_t)nxt.pm * tstepA : cA; const char* nB = has_next ? (const char*)g.Bt + (size_t)nxt.pn * tstep : cB;
        for (int t = 0; t < nt; t += 2) {
            const bool last = (t == nt - 2);
            const char* a1 = cA + (size_t)(t + 1) * kstep;
            const char* a2 = last ? nA : cA + (size_t)(t + 2) * kstep; const char* b2 = last ? nB : cB + (size_t)(t + 2) * kstep;
            const char* a3 = a2 + kstep; const char* b3 = b2 + kstep;
            if (last && has_next) S.a_ready(nxt);
            if (last) E.pre(cur, wid, lane);
            if constexpr (SP2) {
            PG8_LDB(B0, 0, 0); PG8_LDB(B1, 0, 1); PG8_SCHED; PG8_LDA(At, 0, 0); PG8_STAGE(PG8_SA(1, 1), a1 + hstepA, voffA);
            PG8_WAIT_V(8); PG8_WAIT_L(0); PG8_BAR; PG8_MMA(0, 0, At, B0); PG8_MMA(0, 1, At, B1); PG8_BAR; PG8_SCHED;
            PG8_LDA(At, 0, 1); PG8_STAGE(PG8_SB(0, 0), b2, voffB); PG8_STAGE(PG8_SB(0, 1), b2 + hstep, voffB); PG8_STAGE(PG8_SA(0, 0), a2, voffA);
            PG8_WAIT_V(8); PG8_WAIT_L(0); PG8_BAR; PG8_MMA(1, 0, At, B0); PG8_MMA(1, 1, At, B1); PG8_BAR; PG8_SCHED;
            PG8_LDB(B0, 1, 0); PG8_LDB(B1, 1, 1); PG8_SCHED; PG8_LDA(At, 1, 0); PG8_STAGE(PG8_SA(0, 1), a2 + hstepA, voffA);
            PG8_WAIT_V(8); PG8_WAIT_L(0); PG8_BAR; PG8_MMA(0, 0, At, B0); PG8_MMA(0, 1, At, B1); PG8_BAR; PG8_SCHED;
            PG8_LDA(At, 1, 1); PG8_STAGE(PG8_SB(1, 0), b3, voffB); PG8_STAGE(PG8_SB(1, 1), b3 + hstep, voffB); PG8_STAGE(PG8_SA(1, 0), a3, voffA);
            PG8_WAIT_V(8); PG8_WAIT_L(0); PG8_BAR; PG8_MMA(1, 0, At, B0); PG8_MMA(1, 1, At, B1); PG8_BAR; PG8_SCHED;
            } else {
            PG8_LDB(B0, 0, 0); PG8_SCHED; PG8_LDA(At, 0, 0); PG8_STAGE(PG8_SA(1, 1), a1 + hstepA, voffA);
            PG8_WAIT_L(8); PG8_BAR; PG8_WAIT_L(0); PG8_MMA(0, 0, At, B0); PG8_BAR; PG8_SCHED;
            PG8_LDB(B1, 0, 1); PG8_STAGE(PG8_SB(0, 0), b2, voffB);
            PG8_BAR; PG8_WAIT_L(0); PG8_MMA(0, 1, At, B1); PG8_BAR;
            PG8_LDA(At, 0, 1); PG8_STAGE(PG8_SA(0, 0), a2, voffA);
            PG8_BAR; PG8_WAIT_L(0); PG8_MMA(1, 0, At, B0); PG8_BAR; PG8_SCHED;
            PG8_STAGE(PG8_SB(0, 1), b2 + hstep, voffB);
            PG8_WAIT_V(6); PG8_BAR; PG8_MMA(1, 1, At, B1); PG8_BAR;
            PG8_LDB(B0, 1, 0); PG8_SCHED; PG8_LDA(At, 1, 0); PG8_STAGE(PG8_SA(0, 1), a2 + hstepA, voffA);
            PG8_WAIT_L(8); PG8_BAR; PG8_WAIT_L(0); PG8_MMA(0, 0, At, B0); PG8_BAR; PG8_SCHED;
            PG8_LDB(B1, 1, 1); PG8_STAGE(PG8_SB(1, 0), b3, voffB);
            PG8_BAR; PG8_WAIT_L(0); PG8_MMA(0, 1, At, B1); PG8_BAR;
            PG8_LDA(At, 1, 1); PG8_STAGE(PG8_SA(1, 0), a3, voffA);
            PG8_BAR; PG8_WAIT_L(0); PG8_MMA(1, 0, At, B0); PG8_BAR; PG8_SCHED;
            PG8_STAGE(PG8_SB(1, 1), b3 + hstep, voffB);
            PG8_WAIT_V(6); PG8_BAR; PG8_MMA(1, 1, At, B1); PG8_BAR;
            }
        }
        if constexpr (ALIGN_EPI) { if (wr == 0) PG8_BAR; }
        if constexpr (!Epi::AFTER_DRAIN) { E(acc, cur, wr, wc, fr, fq); S.done(cur); }
        if (!has_next) break;
#pragma unroll
        for (int a = 0; a < 2; ++a)
#pragma unroll
            for (int b = 0; b < 2; ++b)
#pragma unroll
                for (int m = 0; m < 4; ++m)
#pragma unroll
                    for (int n = 0; n < 2; ++n) acc[a][b][m][n] = zero4();
        cur = nxt; cA = nA; cB = nB; ++ui;
        if constexpr (ALIGN_EPI) { if (wr == 1) PG8_BAR; }
    }
    PG8_WAIT_V(0);
    if constexpr (!ALIGN_EPI) { if (wr == 0) PG8_BAR; }
    PG8_BAR;
    if constexpr (Epi::AFTER_DRAIN) { E.fused(acc, cur, wr, wc, fr, fq, lds, wid, lane); S.done(cur); }
#undef PG8_SA
#undef PG8_SB
#undef PG8_STAGE
#undef PG8_LDA
#undef PG8_LDB
#undef PG8_MMA
#undef PG8_WAIT_V
#undef PG8_WAIT_L
#undef PG8_BAR
#undef PG8_SCHED
}
}
constexpr int DM = 2048, NSEQ = 10, SEQL = 4096, M = NSEQ * SEQL, M_PROMPT = 8 * SEQL;
constexpr int DA = 1024, DB = 1024, DH = 128, HA = 8, DFF = 8192, DINAB = 6144, DC2 = 4096, DHALF = 3072;
constexpr int EMB = 33, FO = 64, KLEN = 2 * SEQL, RVF_PITCH = KLEN + 32;
constexpr float EPS = 1e-6f;
constexpr int NWAVES = 8, NTHR = 512;

constexpr size_t MiB = 1u << 20;
constexpr size_t WS_CTL = 0, CTL_ZERO_BYTES = 32 * 1024;
constexpr size_t WS_INVS = 1 * MiB + 768 * 1024;
constexpr size_t WS_WIN = 2 * MiB;
constexpr size_t WS_WOUT = 26 * MiB;
constexpr size_t WS_W1 = 34 * MiB;
constexpr size_t WS_W2 = 66 * MiB;
constexpr size_t WS_FILT = 98 * MiB;
constexpr size_t WS_XB = 130 * MiB;
constexpr size_t WS_BIG = 290 * MiB;
constexpr size_t WS_WIN2 = 930 * MiB;
constexpr size_t WS_WOUT2 = 954 * MiB;
constexpr size_t WS_SSA = 962 * MiB;
constexpr size_t WS_SSB = 968 * MiB;
constexpr size_t WS_RVS = 974 * MiB;
constexpr size_t WS_RVF = 980 * MiB;
constexpr size_t WS_END = 997 * MiB;
constexpr size_t BIG_PA = 0, BIG_PB = 240 * MiB, BIG_UT = 480 * MiB, BIG_X0T = 560 * MiB;

constexpr int CW_BAR = 4096;

constexpr int RING_BYTES = 131072;
constexpr int LDS_BYTES = 163840;
constexpr int MISC_OFF = LDS_BYTES - 128;

#define GAS __attribute__((address_space(1)))
#define LAS __attribute__((address_space(3)))
typedef unsigned short bf16;
typedef unsigned v4u __attribute__((ext_vector_type(4)));
typedef unsigned v2u __attribute__((ext_vector_type(2)));
typedef float f32x4 __attribute__((ext_vector_type(4)));
typedef GAS unsigned gu32;
typedef const GAS float* gcf; typedef GAS float* gf; typedef const GAS unsigned short* gcb; typedef GAS unsigned short* gb;
#define RLX_AGENT __ATOMIC_RELAXED, __HIP_MEMORY_SCOPE_AGENT
#define LDS_WAIT() asm volatile("s_waitcnt lgkmcnt(0)" ::: "memory")
#define VM_WAIT() asm volatile("s_waitcnt vmcnt(0)" ::: "memory")
__device__ __forceinline__ unsigned f2bf(float f) { unsigned u = __builtin_bit_cast(unsigned, f); return (u + 0x7fffu + ((u >> 16) & 1u)) >> 16; }
__device__ __forceinline__ unsigned pk2(float lo, float hi) { unsigned r; asm("v_cvt_pk_bf16_f32 %0, %1, %2" : "=v"(r) : "v"(lo), "v"(hi)); return r; }
__device__ __forceinline__ float bflo(unsigned w) { return __builtin_bit_cast(float, w << 16); }
__device__ __forceinline__ float bfhi(unsigned w) { return __builtin_bit_cast(float, w & 0xffff0000u); }
__device__ __forceinline__ float bf2f(bf16 v) { return __builtin_bit_cast(float, (unsigned)v << 16); }
template <int X> __device__ __forceinline__ float swz_xor(float v) { return __builtin_bit_cast(float, __builtin_amdgcn_ds_swizzle(__builtin_bit_cast(int, v), (X << 10) | 0x1F)); }
__device__ __forceinline__ float half_swap(float v) { const unsigned u = __builtin_bit_cast(unsigned, v); const auto q = __builtin_amdgcn_permlane32_swap(u, u, false, false);
    return __builtin_bit_cast(float, (unsigned)q[0]) + __builtin_bit_cast(float, (unsigned)q[1]) - v; }
__device__ __forceinline__ float wave_sum(float v) {
    v += swz_xor<1>(v); v += swz_xor<2>(v); v += swz_xor<4>(v); v += swz_xor<8>(v); v += swz_xor<16>(v);
    const unsigned u = __builtin_bit_cast(unsigned, v); const auto q = __builtin_amdgcn_permlane32_swap(u, u, false, false);
    return __builtin_bit_cast(float, (unsigned)q[0]) + __builtin_bit_cast(float, (unsigned)q[1]);
}

#define XB_TMO      128
#define XB_XCNT(j)  (256  + 64 * (j))
#define XB_XSUB(j)  (1280 + 64 * (j))
#define XB_XGEN(j)  (2304 + 64 * (j))
#define XB_TOP      3328
#define XB_TOPGEN   3392
#define XCD_BAR_WORDS 3456
#define XB_SPIN_CAP (1u << 22)

__device__ __forceinline__ unsigned xb_ld(unsigned* p)              { return __hip_atomic_load(p, __ATOMIC_RELAXED, __HIP_MEMORY_SCOPE_AGENT); }
__device__ __forceinline__ unsigned xb_add(unsigned* p, unsigned v) { return __hip_atomic_fetch_add(p, v, __ATOMIC_RELAXED, __HIP_MEMORY_SCOPE_AGENT); }
__device__ __forceinline__ unsigned xb_xcc_id() { return (unsigned)__builtin_amdgcn_s_getreg((3 << 11) | 20) & 0xFu; }
#define XB_SPIN(cond, bar) do { unsigned _sp = 0; while (cond) { __builtin_amdgcn_s_sleep(1); \
    if ((++_sp & 255u) == 0u) { if (xb_ld(&(bar)[XB_TMO])) break; if (_sp > XB_SPIN_CAP) { atomicAdd(&(bar)[XB_TMO], 1u); break; } } } } while (0)

struct XcdBarrier {
    unsigned* bar; unsigned x;
    volatile LAS unsigned* st;
};

__device__ __forceinline__ XcdBarrier xcd_barrier_post(unsigned* bar, volatile LAS unsigned* st) {
    XcdBarrier b; b.bar = bar; b.x = xb_xcc_id(); b.st = st;
    if (threadIdx.x == 0) (void)xb_add(&bar[XB_XCNT(b.x)], 1u);
    return b;
}
__device__ __forceinline__ void xcd_barrier_complete(unsigned* bar, unsigned x, unsigned& nloc, unsigned& nx) {
    const unsigned G = gridDim.x * gridDim.y * gridDim.z;
    unsigned sum, cnt, mine, sp = 0u;
    for (;;) {
        sum = 0u; cnt = 0u; mine = 0u;
#pragma unroll
        for (unsigned j = 0; j < 16; ++j) { const unsigned c = xb_ld(&bar[XB_XCNT(j)]); sum += c; cnt += (c > 0u) ? 1u : 0u; mine = (j == x) ? c : mine; }
        if (sum == G) break;
        __builtin_amdgcn_s_sleep(1);
        if ((++sp & 255u) == 0u) { if (xb_ld(&bar[XB_TMO])) break; if (sp > XB_SPIN_CAP) { atomicAdd(&bar[XB_TMO], 1u); break; } }
    }
    nloc = mine > 0u ? mine : 1u; nx = cnt > 0u ? cnt : 1u;
}

__device__ __forceinline__ void xcd_barrier(const XcdBarrier& b) {
    asm volatile("s_waitcnt vmcnt(0)" ::: "memory");
    __syncthreads();
    if (threadIdx.x == 0) {
        unsigned* bar = b.bar;
        __builtin_amdgcn_s_waitcnt(0);
        unsigned nloc = b.st[0], nx = b.st[1];
        if (nloc == 0u) { xcd_barrier_complete(bar, b.x, nloc, nx); b.st[0] = nloc; b.st[1] = nx; }
        const unsigned old = xb_add(&bar[XB_XSUB(b.x)], 1u);
        const unsigned gen = old / nloc;
        if (old + 1u == (gen + 1u) * nloc) {
            __builtin_amdgcn_fence(__ATOMIC_RELEASE, "agent");
            asm volatile("s_waitcnt vmcnt(0)" ::: "memory");
            const unsigned og = xb_add(&bar[XB_TOP], 1u);
            const unsigned tg = og / nx;
            if (og + 1u == (tg + 1u) * nx) xb_add(&bar[XB_TOPGEN], 1u);
            else XB_SPIN(xb_ld(&bar[XB_TOPGEN]) == tg, bar);
            __builtin_amdgcn_fence(__ATOMIC_ACQUIRE, "agent");
            xb_add(&bar[XB_XGEN(b.x)], 1u);
            asm volatile("s_waitcnt vmcnt(0)" ::: "memory");
        } else {
            XB_SPIN(xb_ld(&bar[XB_XGEN(b.x)]) == gen, bar);
            __builtin_amdgcn_fence(__ATOMIC_ACQUIRE, "agent");
            asm volatile("s_waitcnt vmcnt(0)" ::: "memory");
        }
    }
    __syncthreads();
}


struct Frame {
    LAS unsigned char* lds;
    volatile LAS unsigned* MISC;
    gu32* ctl;
    int tid, lane, wave;
    int vcu, G, bx, wbase;
    gcf xp, xs; gf out;
    GAS unsigned char* ws;
    gb W1, W2, XB;
    gf FILT, RVS, INVS; gb RVF, SSA, SSB;
};
struct Params { const float* in[27]; float* out; unsigned char* ws; int ph_lo, ph_hi; };

__device__ __forceinline__ gcf xrow_ptr(const Frame& F, int layer, int m) {
    if (layer == 0) return m < M_PROMPT ? F.xp + (size_t)m * DM : F.xs + (size_t)(m - M_PROMPT) * DM;
    return F.out + (size_t)m * DM;
}

__device__ __forceinline__ void xb_rows(Frame& F) {
    const int gw = F.vcu * NWAVES + F.wave, NGW = F.G * NWAVES;
    static_assert(M % 2 == 0, "xb_rows row pairs");
    for (int m0 = gw; m0 < M; m0 += 2 * NGW) {
        const int m1 = m0 + NGW; const bool two = m1 < M;
        const GAS f32x4* xr0 = (const GAS f32x4*)xrow_ptr(F, 0, m0) + F.lane;
        const GAS f32x4* xr1 = (const GAS f32x4*)xrow_ptr(F, 0, two ? m1 : m0) + F.lane;
        f32x4 v[2][8];
#pragma unroll
        for (int j = 0; j < 8; ++j) v[0][j] = xr0[64 * j];
#pragma unroll
        for (int j = 0; j < 8; ++j) v[1][j] = xr1[64 * j];
#pragma unroll
        for (int rr = 0; rr < 2; ++rr) {
            if (rr == 1 && !two) break;
            const int m = rr ? m1 : m0; float s = 0.f;
#pragma unroll
            for (int j = 0; j < 8; ++j) s += (v[rr][j].x * v[rr][j].x + v[rr][j].y * v[rr][j].y) + (v[rr][j].z * v[rr][j].z + v[rr][j].w * v[rr][j].w);
            s = wave_sum(s);
            GAS unsigned long long* o8 = (GAS unsigned long long*)(F.XB + (size_t)m * DM) + F.lane;
#pragma unroll
            for (int j = 0; j < 8; ++j) o8[64 * j] = (unsigned long long)pk2(v[rr][j].x, v[rr][j].y) | ((unsigned long long)pk2(v[rr][j].z, v[rr][j].w) << 32);
            { const float h0 = bfhi(pk2(0.f, s)), h1 = bfhi(pk2(0.f, s - h0)), h2 = s - h0 - h1;
              if (F.lane < 32) F.SSA[(size_t)m * 32 + F.lane] = (bf16)(pk2(F.lane == 0 ? h0 : (F.lane == 1 ? h1 : (F.lane == 2 ? h2 : 0.f)), 0.f) & 0xffffu); }
        }
    }
}
__device__ __forceinline__ void zero_f32(Frame& F, gf p, int n) {
    for (int i = F.vcu * NTHR + F.tid; i < n / 4; i += F.G * NTHR) ((GAS f32x4*)p)[i] = pg8::zero4();
}
__device__ __forceinline__ void transpose_item(gcf W, gcf gain, int K, int N, gb WT, LAS float* scr, int item, int lane) {
    const int nblk = N / 64, kb = item / nblk, nb = item % nblk, k0 = 64 * kb, n0 = 64 * nb;
    const int lr = lane >> 4, lc = lane & 15;
    f32x4 v[16];
#pragma unroll
    for (int i = 0; i < 16; ++i) v[i] = *(const GAS f32x4*)(W + (size_t)(k0 + 4 * i + lr) * N + n0 + 4 * lc);
    float gk[16];
    if (gain) {
#pragma unroll
        for (int i = 0; i < 16; ++i) gk[i] = gain[k0 + 4 * i + lr];
    } else {
#pragma unroll
        for (int i = 0; i < 16; ++i) gk[i] = 1.0f;
    }
#pragma unroll
    for (int i = 0; i < 16; ++i) asm volatile("" : "+v"(gk[i]));
#pragma unroll
    for (int i = 0; i < 16; ++i) *(LAS f32x4*)(scr + (4 * i + lr) * 68 + 4 * lc) = v[i] * gk[i];
    LDS_WAIT(); asm volatile("" ::: "memory");
    const int kc = lane & 7, nr = lane >> 3;
#pragma unroll
    for (int j = 0; j < 8; ++j) { const int n = 8 * j + nr; const LAS float* s = scr + (8 * kc) * 68 + n;
        v4u o; o.x = pk2(s[0 * 68], s[1 * 68]); o.y = pk2(s[2 * 68], s[3 * 68]); o.z = pk2(s[4 * 68], s[5 * 68]); o.w = pk2(s[6 * 68], s[7 * 68]);
        *(GAS v4u*)(WT + (size_t)(n0 + n) * K + k0 + 8 * kc) = o; }
    LDS_WAIT(); asm volatile("" ::: "memory");
}
struct CvtJob { gcf W; gcf gain; gb T; int K, N; };
template <int NJ> __device__ __forceinline__ void convert_jobs(Frame& F, const CvtJob (&jobs)[NJ], int lds_off) {
    LAS float* scr = (LAS float*)(F.lds + lds_off + F.wave * 17408);
    const int gw = F.vcu * NWAVES + F.wave, NGW = F.G * NWAVES;
    int total = 0;
#pragma unroll
    for (int q = 0; q < NJ; ++q) total += (jobs[q].K / 64) * (jobs[q].N / 64);
    for (int it = gw; it < total; it += NGW) {
        int r = it;
#pragma unroll
        for (int q = 0; q < NJ; ++q) { const int I = (jobs[q].K / 64) * (jobs[q].N / 64);
            if (r >= 0 && r < I) transpose_item(jobs[q].W, jobs[q].gain, jobs[q].K, jobs[q].N, jobs[q].T, scr, r, F.lane);
            r -= I; }
    }
}

template <class P> __device__ __forceinline__ P unif_ptr(P p) { const unsigned long long v = (unsigned long long)p;
    const unsigned lo = __builtin_amdgcn_readfirstlane((unsigned)v), hi = __builtin_amdgcn_readfirstlane((unsigned)(v >> 32)); return (P)(((unsigned long long)hi << 32) | lo); }
__device__ __forceinline__ void filter_gen(Frame& F, gcf fw1v, gcf fb1v, gcf fw2v, gcf fb2v, gcf fw3v, gcf fb3v,
                                           gcf fwoutv, gcf ffreqv) {
    gcf fw1 = unif_ptr(fw1v), fb1 = unif_ptr(fb1v), fw2 = unif_ptr(fw2v), fb2 = unif_ptr(fb2v), fw3 = unif_ptr(fw3v), fb3 = unif_ptr(fb3v), fwout = unif_ptr(fwoutv), ffreq = unif_ptr(ffreqv);
    LAS float* zf = (LAS float*)(F.lds);
    LAS float* ha = zf + 16 * 36;
    LAS float* hb = ha + 16 * 64;
    for (int unit = F.bx; unit < SEQL / 16; unit += F.G) {
        const int t0 = unit * 16;
        __syncthreads();
        for (int e = F.tid; e < 16 * EMB; e += NTHR) {
            const int tl = e / EMB, k = e % EMB, t = t0 + tl;
            const float tlin = (float)t / (float)(SEQL - 1);
            const float w = 6.283185307179586f * (float)t / (float)SEQL;
            float z;
            if (k == 0) z = tlin;
            else { const int kk = (k - 1) & 15; const float fk = 1e-4f + (float)kk * ((15.0f - 1e-4f) / 15.0f); z = (k <= 16) ? cosf(fk * w) : -sinf(fk * w); }
            zf[tl * 36 + k] = z;
        }
        __syncthreads();
        static_assert(EMB % 11 == 0 && FO % 16 == 0 && NTHR == 8 * FO, "filter MLP load batches / thread map");
#define FG_MAP int ts_ = F.tid; asm volatile("" : "+v"(ts_)); const int o_ = ts_ & (FO - 1), tl0 = ts_ >> 6
        { FG_MAP; float s0 = fb1[o_], s1 = s0;
            for (int k0 = 0; k0 < EMB; k0 += 11) { float wv[11];
#pragma unroll
                for (int j = 0; j < 11; ++j) wv[j] = fw1[(k0 + j) * FO + o_];
#pragma unroll
                for (int j = 0; j < 11; ++j) asm volatile("" : "+v"(wv[j]));
#pragma unroll
                for (int j = 0; j < 11; ++j) { s0 += zf[tl0 * 36 + k0 + j] * wv[j]; s1 += zf[(tl0 + 8) * 36 + k0 + j] * wv[j]; } }
            const float fq_ = ffreq[o_]; ha[tl0 * FO + o_] = sinf(fq_ * s0); ha[(tl0 + 8) * FO + o_] = sinf(fq_ * s1); }
        __syncthreads();
        { FG_MAP; float s0 = fb2[o_], s1 = s0;
            for (int k0 = 0; k0 < FO; k0 += 16) { float wv[16];
#pragma unroll
                for (int j = 0; j < 16; ++j) wv[j] = fw2[(k0 + j) * FO + o_];
#pragma unroll
                for (int j = 0; j < 16; ++j) asm volatile("" : "+v"(wv[j]));
#pragma unroll
                for (int j = 0; j < 16; ++j) { s0 += ha[tl0 * FO + k0 + j] * wv[j]; s1 += ha[(tl0 + 8) * FO + k0 + j] * wv[j]; } }
            const float fq_ = ffreq[o_]; hb[tl0 * FO + o_] = sinf(fq_ * s0); hb[(tl0 + 8) * FO + o_] = sinf(fq_ * s1); }
        __syncthreads();
        { FG_MAP; float s0 = fb3[o_], s1 = s0;
            for (int k0 = 0; k0 < FO; k0 += 16) { float wv[16];
#pragma unroll
                for (int j = 0; j < 16; ++j) wv[j] = fw3[(k0 + j) * FO + o_];
#pragma unroll
                for (int j = 0; j < 16; ++j) asm volatile("" : "+v"(wv[j]));
#pragma unroll
                for (int j = 0; j < 16; ++j) { s0 += hb[tl0 * FO + k0 + j] * wv[j]; s1 += hb[(tl0 + 8) * FO + k0 + j] * wv[j]; } }
            const float fq_ = ffreq[o_]; ha[o_ * 16 + tl0] = sinf(fq_ * s0); ha[o_ * 16 + tl0 + 8] = sinf(fq_ * s1); }
        __syncthreads();
#undef FG_MAP
        for (int q = 0; q < 4; ++q) {
            int tq_ = F.tid; asm volatile("" : "+v"(tq_));
            const int o = tq_ + NTHR * q;
            float acc[16];
#pragma unroll
            for (int i = 0; i < 16; ++i) acc[i] = 0.f;
            for (int k0 = 0; k0 < FO; k0 += 16) { float wq[16];
#pragma unroll
              for (int j = 0; j < 16; ++j) wq[j] = fwout[(k0 + j) * (2 * DB) + o];
#pragma unroll
              for (int j = 0; j < 16; ++j) asm volatile("" : "+v"(wq[j]));
#pragma unroll
              for (int j = 0; j < 16; ++j) { const int k = k0 + j; const float wv = wq[j];
                const f32x4 h0 = *(const LAS f32x4*)(ha + k * 16), h1 = *(const LAS f32x4*)(ha + k * 16 + 4), h2 = *(const LAS f32x4*)(ha + k * 16 + 8), h3 = *(const LAS f32x4*)(ha + k * 16 + 12);
                acc[0] += h0[0] * wv; acc[1] += h0[1] * wv; acc[2] += h0[2] * wv; acc[3] += h0[3] * wv; acc[4] += h1[0] * wv; acc[5] += h1[1] * wv; acc[6] += h1[2] * wv; acc[7] += h1[3] * wv;
                acc[8] += h2[0] * wv; acc[9] += h2[1] * wv; acc[10] += h2[2] * wv; acc[11] += h2[3] * wv; acc[12] += h3[0] * wv; acc[13] += h3[1] * wv; acc[14] += h3[2] * wv; acc[15] += h3[3] * wv; } }
            const int c = o & (DB - 1);
            const float dlo = -15.350567286626973f, dhi = -3.0701134573253945f;
            const float delta = fabsf(dlo + (float)c * ((dhi - dlo) / (float)(DB - 1)));
            gf frow = F.FILT + (size_t)c * KLEN;
            gb rrow = F.RVF + (size_t)c * RVF_PITCH;
            float v[16];
#pragma unroll
            for (int i = 0; i < 16; ++i) { const int t = t0 + i; const float tlin = (float)t / (float)(SEQL - 1); v[i] = acc[i] * expf(-tlin * delta); }
            if (o < DB) {
#pragma unroll
                for (int i4 = 0; i4 < 4; ++i4) *(GAS f32x4*)(frow + t0 + 4 * i4) = (f32x4){v[4 * i4], v[4 * i4 + 1], v[4 * i4 + 2], v[4 * i4 + 3]};
                gb rs_ = rrow + (SEQL - t0);
                rs_[0] = (bf16)f2bf(v[0]);
                *(GAS v4u*)(rs_ - 8) = (v4u){pk2(v[8], v[7]), pk2(v[6], v[5]), pk2(v[4], v[3]), pk2(v[2], v[1])};
                *(GAS v2u*)(rs_ - 12) = (v2u){pk2(v[12], v[11]), pk2(v[10], v[9])};
                *(GAS unsigned*)(rs_ - 14) = pk2(v[14], v[13]);
                rs_[-15] = (bf16)f2bf(v[15]);
            } else {
                gf fs_ = frow + (KLEN - t0);
                *(GAS f32x4*)(fs_ - 4) = (f32x4){v[4], v[3], v[2], v[1]};
                *(GAS f32x4*)(fs_ - 8) = (f32x4){v[8], v[7], v[6], v[5]};
                *(GAS f32x4*)(fs_ - 12) = (f32x4){v[12], v[11], v[10], v[9]};
                *(GAS v2u*)(fs_ - 14) = (v2u){__builtin_bit_cast(unsigned, v[14]), __builtin_bit_cast(unsigned, v[13])};
                fs_[-15] = v[15];
                gb rs_ = rrow + (SEQL + t0);
                *(GAS v4u*)(rs_ + 8) = (v4u){pk2(v[8], v[9]), pk2(v[10], v[11]), pk2(v[12], v[13]), pk2(v[14], v[15])};
                if (t0 > 0) { fs_[0] = v[0]; *(GAS v4u*)rs_ = (v4u){pk2(v[0], v[1]), pk2(v[2], v[3]), pk2(v[4], v[5]), pk2(v[6], v[7])}; }
                else { frow[SEQL] = 0.f; rrow[0] = 0;
#pragma unroll
                    for (int i = 1; i < 8; ++i) rs_[i] = (bf16)f2bf(v[i]); }
            }
            if (unit == 0 && o < DB) {
#pragma unroll
                for (int i4 = 0; i4 < 4; ++i4) *(GAS v4u*)(rrow + KLEN + 8 * i4) = (v4u){0u, 0u, 0u, 0u};
            }
        }
    }
}

struct PrepRegs { v4u x[3][3]; };
__device__ __forceinline__ void prep_load(PrepRegs& R, gcb PB, int cb, int bt, int tl, int cv) {
    const int b = bt >> 6, tb = bt & 63, t = tb * 64 + tl, c = cb * 64 + 8 * cv;
    gcb p = PB + ((size_t)b * SEQL + t) * DHALF + c;
#pragma unroll
    for (int part = 0; part < 3; ++part) {
        R.x[part][0] = (t > 0) ? *(const GAS v4u*)(p + part * DB - DHALF) : (v4u){0u, 0u, 0u, 0u};
        R.x[part][1] = *(const GAS v4u*)(p + part * DB);
        R.x[part][2] = (t < SEQL - 1) ? *(const GAS v4u*)(p + part * DB + DHALF) : (v4u){0u, 0u, 0u, 0u};
    }
}
struct PrepW { f32x4 w[3][2]; f32x4 b[2]; };
__device__ __forceinline__ void prep_weights(PrepW& W, gcf scw, gcf scb, int col) {
#pragma unroll
    for (int k = 0; k < 3; ++k) { W.w[k][0] = *(const GAS f32x4*)(scw + k * DHALF + col); W.w[k][1] = *(const GAS f32x4*)(scw + k * DHALF + col + 4); }
    W.b[0] = *(const GAS f32x4*)(scb + col); W.b[1] = *(const GAS f32x4*)(scb + col + 4);
}
__device__ __forceinline__ void conv8(float (&z)[8], const v4u (&x)[3], const PrepW& W) {
#pragma unroll
    for (int e = 0; e < 8; ++e) z[e] = (e < 4) ? W.b[0][e] : W.b[1][e - 4];
#pragma unroll
    for (int k = 0; k < 3; ++k) { const v4u v = x[k];
        z[0] += bflo(v.x) * W.w[k][0][0]; z[1] += bfhi(v.x) * W.w[k][0][1]; z[2] += bflo(v.y) * W.w[k][0][2]; z[3] += bfhi(v.y) * W.w[k][0][3];
        z[4] += bflo(v.z) * W.w[k][1][0]; z[5] += bfhi(v.z) * W.w[k][1][1]; z[6] += bflo(v.w) * W.w[k][1][2]; z[7] += bfhi(v.w) * W.w[k][1][3]; }
}
__device__ __forceinline__ void hyena_prep(Frame& F, gcb PB, gb UT, gb X0T, gcf scw, gcf scb) {
    LAS bf16* tu = (LAS bf16*)(F.lds);
    LAS bf16* tx = tu + 64 * 72;
    const int tl = F.tid >> 3, cv = F.tid & 7;
    const int NBT = NSEQ * 64, nb = F.G >> 4, cb = F.bx & 15;
    if ((F.G & 15) != 0 || nb == 0) return;
    PrepW W0, W1, W2;
    prep_weights(W0, scw, scb, cb * 64 + 8 * cv); prep_weights(W1, scw, scb, DB + cb * 64 + 8 * cv); prep_weights(W2, scw, scb, 2 * DB + cb * 64 + 8 * cv);
    int bt = F.bx >> 4;
    PrepRegs R;
    if (bt < NBT) prep_load(R, PB, cb, bt, tl, cv);
    for (; bt < NBT; bt += nb) {
        float z0[8], z1[8], z2[8];
        conv8(z0, R.x[0], W0); conv8(z1, R.x[1], W1); conv8(z2, R.x[2], W2);
        if (bt + nb < NBT) prep_load(R, PB, cb, bt + nb, tl, cv);
        __syncthreads();
#pragma unroll
        for (int e = 0; e < 8; ++e) { tu[(8 * cv + e) * 72 + tl] = (bf16)f2bf(z2[e] * z1[e]); tx[(8 * cv + e) * 72 + tl] = (bf16)f2bf(z0[e]); }
        __syncthreads();
        const int cl = F.tid >> 3, tc = F.tid & 7, b = bt >> 6, tb = bt & 63;
        const size_t o = ((size_t)(cb * 64 + cl) * NSEQ + b) * SEQL + tb * 64 + 8 * tc;
        *(GAS v4u*)(UT + o) = *(const LAS v4u*)(tu + cl * 72 + 8 * tc);
        *(GAS v4u*)(X0T + o) = *(const LAS v4u*)(tx + cl * 72 + 8 * tc);
    }
}
__device__ __forceinline__ void filter_norm(Frame& F) {
    const int gw = F.vcu * NWAVES + F.wave, NGW = F.G * NWAVES;
    for (int c = gw; c < DB; c += NGW) {
        const GAS f32x4* p = (const GAS f32x4*)(F.FILT + (size_t)c * KLEN) + F.lane; float s = 0.f;
        for (int j0 = 0; j0 < KLEN / 256; j0 += 16) { f32x4 v[16];
#pragma unroll
            for (int j = 0; j < 16; ++j) v[j] = p[64 * (j0 + j)];
#pragma unroll
            for (int j = 0; j < 16; ++j) asm volatile("" : "+v"(v[j]));
#pragma unroll
            for (int j = 0; j < 16; ++j) s += (fabsf(v[j].x) + fabsf(v[j].y)) + (fabsf(v[j].z) + fabsf(v[j].w)); }
        s = wave_sum(s);
        if (F.lane == 0) F.INVS[c] = 1.f / s;
    }
}
constexpr int HY_C_OFF = 92416;
constexpr int HY_CS = 8704;
constexpr int HY_Z_OFF = HY_C_OFF + 8 * HY_CS;
static_assert(HY_Z_OFF + 128 <= MISC_OFF, "hyena LDS map");
typedef short bf16x8_t __attribute__((ext_vector_type(8)));
template <bool PRE>
__device__ __forceinline__ void hyena_build_copies(Frame& F, gcb rv, int zmin, int nz, v4u A0 = (v4u){0u, 0u, 0u, 0u}, v4u B0 = (v4u){0u, 0u, 0u, 0u}) {
    for (int zi = F.tid; zi < nz; zi += NTHR) {
        gcb p = rv + SEQL + zmin + 8 * zi;
        v4u A, B;
        if (PRE && zi < NTHR) { A = A0; B = B0; } else { A = *(const GAS v4u*)p; B = *(const GAS v4u*)(p + 8); }
        const unsigned d[8] = {A.x, A.y, A.z, A.w, B.x, B.y, B.z, B.w};
#pragma unroll
        for (int s = 0; s < 8; ++s) {
            v4u o;
            if ((s & 1) == 0) { o.x = d[s / 2]; o.y = d[s / 2 + 1]; o.z = d[s / 2 + 2]; o.w = d[s / 2 + 3]; }
            else { const int q = (s - 1) / 2;
                o.x = __builtin_amdgcn_alignbit(d[q + 1], d[q], 16); o.y = __builtin_amdgcn_alignbit(d[q + 2], d[q + 1], 16);
                o.z = __builtin_amdgcn_alignbit(d[q + 3], d[q + 2], 16); o.w = __builtin_amdgcn_alignbit(d[q + 4], d[q + 3], 16); }
            *(LAS v4u*)(F.lds + HY_C_OFF + s * HY_CS + 16 * ((0xC0B6E590u >> (4 * s)) & 15u) + 16 * zi) = o;
        }
    }
}
__device__ __forceinline__ void hyena_conv_mfma(Frame& F, gcb UT, gcb X0T, gb GT, gcf hbias) {
    const int lane = F.lane, w = F.wave, m = lane & 15, g = lane >> 4;
    const int sh = (-m) & 7, cc = (m + 7) >> 3;
    const unsigned copyb = HY_C_OFF + sh * HY_CS + 16 * ((0xC0B6E590u >> (4 * sh)) & 15u);
    const int pb = 14 - 2 * w, sb = 8 * w;
    const int dP = m >> 3, dS = m >> 1;
    const unsigned laneBP = (m & 7) * 8192 + 16 * (g ^ (m & 7)), laneBS = (8 + (m & 1)) * 8192, gxS = 16 * (g ^ (m & 1));
    const unsigned zb = HY_Z_OFF + 16 * g;
    for (int c = F.bx; c < DB; c += F.G) {
        gcb rvc = F.RVF + (size_t)c * RVF_PITCH;
        __syncthreads();
        if (F.tid < 8) *(LAS f32x4*)(F.lds + HY_Z_OFF + 16 * F.tid) = pg8::zero4();
        v4u rA, rB;
        { const GAS v4u* src = (const GAS v4u*)(UT + (size_t)c * NSEQ * SEQL);
          int ts = F.tid; asm volatile("" : "+v"(ts));
          const unsigned blk = ts >> 3, chk = ts & 7, fs = ((blk >> 1) & 3) << 1;
          v4u ur[NSEQ];
#pragma unroll
          for (int b = 0; b < NSEQ; ++b) ur[b] = src[b * 512 + ts];
          rA = *(const GAS v4u*)(rvc + SEQL - 4096 + 8 * ts); rB = *(const GAS v4u*)(rvc + SEQL - 4096 + 8 * ts + 8);
          __builtin_amdgcn_sched_barrier(0);
#pragma unroll
          for (int b = 0; b < NSEQ; ++b) { const unsigned f = (b < 8) ? (unsigned)b : ((unsigned)(b & 1) ^ fs); *(LAS v4u*)(F.lds + b * 8192 + blk * 128 + 16 * (chk ^ f)) = ur[b]; } }
        hyena_build_copies<true>(F, rvc, -4096, 520, rA, rB);
        __syncthreads();
        f32x4 acc[5][4];
#pragma unroll
        for (int i = 0; i < 5; ++i)
#pragma unroll
            for (int mt = 0; mt < 4; ++mt) acc[i][mt] = pg8::zero4();
        bf16x8_t A[4][2], An[4][2];
        v4u Bc0, Bc1, Bn0, Bn1, Bs0, Bs1;
#define HY_LDA(dst, base) do { _Pragma("unroll") for (int mt = 0; mt < 4; ++mt) _Pragma("unroll") for (int ks = 0; ks < 2; ++ks) \
            dst[mt][ks] = *(const LAS bf16x8_t*)(F.lds + (base) + (96 - 32 * mt + 64 * ks)); } while (0)
#define HY_LPC(buf, ap) do { const int ab_ = (ap) + dP; const unsigned bo_ = ((unsigned)ab_ < 64u) ? laneBP + 128u * (unsigned)ab_ : zb; \
            buf##0 = *(const LAS v4u*)(F.lds + bo_); buf##1 = *(const LAS v4u*)(F.lds + (bo_ ^ 64u)); __builtin_amdgcn_sched_barrier(0); } while (0)
#define HY_LPU(buf, off) do { buf##0 = *(const LAS v4u*)(F.lds + bq0 + (off)); buf##1 = *(const LAS v4u*)(F.lds + bq1 + (off)); __builtin_amdgcn_sched_barrier(0); } while (0)
#define HY_LS(buf, ap) do { const int ab_ = (ap) + dS; const unsigned bo_ = ((unsigned)ab_ < 64u) ? laneBS + 128u * (unsigned)ab_ + (gxS ^ (((unsigned)ab_ << 4) & 0x60u)) : zb; \
            buf##0 = *(const LAS v4u*)(F.lds + bo_); buf##1 = *(const LAS v4u*)(F.lds + (bo_ ^ 64u)); } while (0)
#define HY_MM(AA, i, buf) do { const bf16x8_t B0_ = __builtin_bit_cast(bf16x8_t, buf##0), B1_ = __builtin_bit_cast(bf16x8_t, buf##1); \
            _Pragma("unroll") for (int mt = 0; mt < 4; ++mt) acc[i][mt] = __builtin_amdgcn_mfma_f32_16x16x32_bf16(AA[mt][0], B0_, acc[i][mt], 0, 0, 0); \
            _Pragma("unroll") for (int mt = 0; mt < 4; ++mt) acc[i][mt] = __builtin_amdgcn_mfma_f32_16x16x32_bf16(AA[mt][1], B1_, acc[i][mt], 0, 0, 0); } while (0)
        {
            const unsigned laneA0 = copyb + 16 * g - 16 * cc + 8192 - 96;
            const int limS = sb + 7;
            int E = 0;
            HY_LDA(A, laneA0);
            HY_LPC(Bc, pb + 48);
            unsigned bq0 = laneBP + 128u * (unsigned)(pb + 15 + dP), bq1 = bq0 ^ 64u;
#define HY_TOP(Y, E_) HY_LDA(Y, laneA0 - 128 * min((E_) + 1, 63)); const bool sa_ = (E_) <= limS; if (sa_) HY_LS(Bs, sb - (E_))
#define HY_END(X) if (sa_) HY_MM(X, 4, Bs)
#define HY_DEC bq0 -= 128u; bq1 -= 128u
#define HY_S0(X, Y, P, Q, E_) { HY_TOP(Y, E_); HY_LPU(Q, 2176); HY_MM(X, 3, P); HY_LPU(P, 128); HY_MM(X, 2, Q); HY_LPC(Q, pb - (E_)); HY_MM(X, 1, P); HY_LPU(P, 4096); HY_MM(X, 0, Q); HY_END(X); HY_DEC; }
#define HY_S1(X, Y, P, Q, E_) { HY_TOP(Y, E_); HY_LPU(Q, 128); HY_MM(X, 3, P); HY_LPC(P, pb + 16 - (E_)); HY_MM(X, 2, Q); HY_LPU(Q, 2048); HY_MM(X, 1, P); HY_END(X); HY_DEC; }
#define HY_S2(X, Y, P, Q, E_) { HY_TOP(Y, E_); HY_LPC(Q, pb + 32 - (E_)); HY_MM(X, 3, P); HY_LPU(P, 0); HY_MM(X, 2, Q); HY_END(X); HY_DEC; }
#define HY_S3(X, Y, P, Q, E_) { HY_TOP(Y, E_); HY_LPC(Q, pb + 47 - (E_)); HY_MM(X, 3, P); HY_END(X); }
#define HY_ST(X, Y, P, Q, E_) { HY_LDA(Y, laneA0 - 128 * min((E_) + 1, 63)); HY_LS(Q, sb - (E_) - 1); HY_MM(X, 4, P); }
            for (; E <= pb + 1; E += 2) { HY_S0(A, An, Bc, Bn, E) HY_S0(An, A, Bc, Bn, E + 1) }
            bq0 += 2048u; bq1 += 2048u;
            for (; E <= pb + 17; E += 2) { HY_S1(A, An, Bc, Bn, E) HY_S1(An, A, Bn, Bc, E + 1) }
            bq0 += 2048u; bq1 += 2048u;
            for (; E <= pb + 33; E += 2) { HY_S2(A, An, Bc, Bn, E) HY_S2(An, A, Bc, Bn, E + 1) }
            for (; E <= pb + 49; E += 2) { HY_S3(A, An, Bc, Bn, E) HY_S3(An, A, Bn, Bc, E + 1) }
            HY_LS(Bc, sb - E);
            for (; E <= limS; E += 2) { HY_ST(A, An, Bc, Bn, E) HY_ST(An, A, Bn, Bc, E + 1) }
#undef HY_TOP
#undef HY_DEC
#undef HY_S0
#undef HY_S1
#undef HY_S2
#undef HY_S3
#undef HY_ST
        }
        __syncthreads();
          hyena_build_copies<false>(F, rvc, 0, 512);
        __syncthreads();
        {
            const unsigned laneA0 = copyb + 16 * g - 16 * cc - 96;
            const int limS = 63 - sb;
            int e = 1;
            HY_LDA(An, laneA0 + 128);
            HY_LPC(Bc, pb + 1);
            unsigned bq0 = laneBP + 128u * (unsigned)(pb + 1 + dP), bq1 = bq0 ^ 64u;
#define HY_TOP(Y, e_) HY_LDA(Y, laneA0 + 128 * min((e_) + 1, 63)); const bool sa_ = (e_) <= limS; if (sa_) HY_LS(Bs, sb + (e_))
#define HY_INC bq0 += 128u; bq1 += 128u
#define HY_P0(X, Y, P, Q, e_) { HY_TOP(Y, e_); HY_LPU(Q, 2048); HY_MM(X, 0, P); HY_LPU(P, 4096); HY_MM(X, 1, Q); HY_LPC(Q, pb + 48 + (e_)); HY_MM(X, 2, P); HY_LPU(P, 128); HY_MM(X, 3, Q); HY_END(X); HY_INC; }
#define HY_P1(X, Y, P, Q, e_) { HY_TOP(Y, e_); HY_LPU(Q, 2048); HY_MM(X, 0, P); HY_LPC(P, pb + 32 + (e_)); HY_MM(X, 1, Q); HY_LPU(Q, 128); HY_MM(X, 2, P); HY_END(X); HY_INC; }
#define HY_P2(X, Y, P, Q, e_) { HY_TOP(Y, e_); HY_LPC(Q, pb + 16 + (e_)); HY_MM(X, 0, P); HY_LPU(P, 128); HY_MM(X, 1, Q); HY_END(X); HY_INC; }
#define HY_P3(X, Y, P, Q, e_) { HY_TOP(Y, e_); HY_LPC(Q, pb + 1 + (e_)); HY_MM(X, 0, P); HY_END(X); }
#define HY_PT(X, Y, P, Q, e_) { HY_LDA(Y, laneA0 + 128 * min((e_) + 1, 63)); HY_LS(Q, sb + (e_) + 1); HY_MM(X, 4, P); }
            HY_P0(An, A, Bc, Bn, e) ++e;
            for (; e <= 15 - pb; e += 2) { HY_P0(A, An, Bc, Bn, e) HY_P0(An, A, Bc, Bn, e + 1) }
            for (; e <= 31 - pb; e += 2) { HY_P1(A, An, Bc, Bn, e) HY_P1(An, A, Bn, Bc, e + 1) }
            for (; e <= 47 - pb; e += 2) { HY_P2(A, An, Bc, Bn, e) HY_P2(An, A, Bc, Bn, e + 1) }
            for (; e <= 63 - pb; e += 2) { HY_P3(A, An, Bc, Bn, e) HY_P3(An, A, Bn, Bc, e + 1) }
            HY_LS(Bc, sb + e);
            for (; e <= limS; e += 2) { HY_PT(A, An, Bc, Bn, e) HY_PT(An, A, Bn, Bc, e + 1) }
#undef HY_TOP
#undef HY_INC
#undef HY_P0
#undef HY_P1
#undef HY_P2
#undef HY_P3
#undef HY_PT
        }
#undef HY_END
#undef HY_LDA
#undef HY_LPC
#undef HY_LPU
#undef HY_LS
#undef HY_MM
        {
            const float is = F.INVS[c], hb = hbias[c];
            int le = F.lane; asm volatile("" : "+v"(le));
            const int m = le & 15, g = le >> 4, dP = m >> 3, dS = m >> 1;
            const int sblk = sb + dS;
            const size_t oP = ((size_t)c * NSEQ + (m & 7)) * SEQL + 64 * (pb + dP) + 4 * g, oS = ((size_t)c * NSEQ + 8 + (m & 1)) * SEQL + 64 * sblk + 4 * g;
            const unsigned uPo = (m & 7) * 8192 + (pb + dP) * 128 + 8 * (g & 1), qP = 16 * ((g >> 1) ^ (m & 7));
            const unsigned uSo = (8 + (m & 1)) * 8192 + sblk * 128 + 8 * (g & 1), qS = 16 * ((g >> 1) ^ (m & 1) ^ (((sblk >> 1) & 3) << 1));
            v2u xq[5][4];
#pragma unroll
            for (int i = 0; i < 5; ++i)
#pragma unroll
                for (int mt = 0; mt < 4; ++mt) xq[i][mt] = *(const GAS v2u*)(X0T + ((i < 4) ? oP + 1024 * i + 16 * mt : oS + 16 * mt));
            __builtin_amdgcn_sched_barrier(0);
#pragma unroll
            for (int i = 0; i < 5; ++i)
#pragma unroll
                for (int mt = 0; mt < 4; ++mt) {
                    const size_t o = (i < 4) ? oP + 1024 * i + 16 * mt : oS + 16 * mt;
                    const unsigned up = (i < 4) ? uPo + 2048 * i + (qP ^ (32 * mt)) : uSo + (qS ^ (32 * mt));
                    const v2u xv = xq[i][mt];
                    const v2u uv = *(const LAS v2u*)(F.lds + up);
                    const f32x4 a4 = acc[i][mt];
                    const float y0 = (a4.x * is + bflo(uv.x) * hb) * bflo(xv.x), y1 = (a4.y * is + bfhi(uv.x) * hb) * bfhi(xv.x);
                    const float y2 = (a4.z * is + bflo(uv.y) * hb) * bflo(xv.y), y3 = (a4.w * is + bfhi(uv.y) * hb) * bfhi(xv.y);
                    *(GAS v2u*)(GT + o) = (v2u){pk2(y0, y1), pk2(y2, y3)};
                }
        }
    }
}
__device__ __forceinline__ void hyena_post(Frame& F, gcb GT, gb O, int ldo) {
    LAS bf16* tl_ = (LAS bf16*)(F.lds);
    for (int unit = F.bx; unit < NSEQ * 64 * 16; unit += F.G) {
        const int cb = unit / (NSEQ * 64), rem = unit % (NSEQ * 64), b = rem >> 6, tb = rem & 63;
        const int cl = F.tid >> 3, tc = F.tid & 7;
        const v4u v = *(const GAS v4u*)(GT + ((size_t)(cb * 64 + cl) * NSEQ + b) * SEQL + tb * 64 + 8 * tc);
        __syncthreads();
        tl_[(8 * tc + 0) * 72 + cl] = (bf16)(v.x & 0xffffu); tl_[(8 * tc + 1) * 72 + cl] = (bf16)(v.x >> 16);
        tl_[(8 * tc + 2) * 72 + cl] = (bf16)(v.y & 0xffffu); tl_[(8 * tc + 3) * 72 + cl] = (bf16)(v.y >> 16);
        tl_[(8 * tc + 4) * 72 + cl] = (bf16)(v.z & 0xffffu); tl_[(8 * tc + 5) * 72 + cl] = (bf16)(v.z >> 16);
        tl_[(8 * tc + 6) * 72 + cl] = (bf16)(v.w & 0xffffu); tl_[(8 * tc + 7) * 72 + cl] = (bf16)(v.w >> 16);
        __syncthreads();
        const int tl = F.tid >> 3, cc = F.tid & 7;
        *(GAS v4u*)(O + ((size_t)b * SEQL + tb * 64 + tl) * ldo + cb * 64 + 8 * cc) = *(const LAS v4u*)(tl_ + tl * 72 + 8 * cc);
    }
}
typedef short s16x4_t __attribute__((ext_vector_type(4)));
template <int NCH> __device__ __forceinline__ unsigned img_off(unsigned row, unsigned ch) { return (128u * NCH) * (row >> 3) + 512u * (ch >> 2) + 64u * (row & 7) + 16u * ((ch & 3) ^ ((row >> 2) & 3)); }
__device__ __forceinline__ s16x4_t ds_tr(const LAS unsigned char* p) { return __builtin_bit_cast(s16x4_t, __builtin_amdgcn_ds_read_tr16_b64_v4i16((LAS s16x4_t*)p)); }
__device__ __forceinline__ float sumsq8(v4u v) {
    const float a0 = bflo(v.x), a1 = bfhi(v.x), a2 = bflo(v.y), a3 = bfhi(v.y), a4 = bflo(v.z), a5 = bfhi(v.z), a6 = bflo(v.w), a7 = bfhi(v.w);
    return ((a0 * a0 + a1 * a1) + (a2 * a2 + a3 * a3)) + ((a4 * a4 + a5 * a5) + (a6 * a6 + a7 * a7));
}
constexpr int AT_RING = 0, AT_RKT = 9 * 16384, AT_RPB = AT_RKT + 2 * 2304, AT_GN = AT_RPB + 2 * 1920;
static_assert(AT_GN + 512 <= MISC_OFF, "attention LDS map");
#define AT_WAIT(n) asm volatile("s_waitcnt vmcnt(" #n ")" ::: "memory")
#define AT_BAR() do { asm volatile("s_waitcnt lgkmcnt(0)" ::: "memory"); __builtin_amdgcn_s_barrier(); asm volatile("" ::: "memory"); } while (0)
struct AtUnit { int b, h, r0, rs0; };
__device__ __forceinline__ AtUnit at_unit(int wu) { AtUnit u; u.b = wu >> 8; u.h = (wu >> 5) & 7; u.r0 = 2 * (wu & 31); u.rs0 = min(max(u.r0 - 4, 0), 56); return u; }
__device__ __forceinline__ void attn_coop(Frame& F, gcb PAv, gb O0v, int ldo, gcf qgv, gcf kgv, gcf rpbv, gcf RKPv) {
    const int w = F.wave;
    gcb PA_ = unif_ptr(PAv); gb O0_ = unif_ptr(O0v); gcf qg_ = unif_ptr(qgv), kg_ = unif_ptr(kgv), rpb_ = unif_ptr(rpbv), RKP_ = unif_ptr(RKPv);
    asm volatile("" : "+s"(PA_), "+s"(O0_), "+s"(qg_), "+s"(kg_), "+s"(rpb_), "+s"(RKP_));
    const int per = (NSEQ * HA * 32 + F.G - 1) / F.G, NUN = NSEQ * HA * 32;
#define AT_WU(k) ((F.G == 256) ? (F.vcu >> 5) * (32 * per) + 32 * (k) + (F.vcu & 31) : F.vcu * per + (k))
#define AT_OFFS(ln_) unsigned offK[2], offV[2]; \
    _Pragma("unroll") for (int i = 0; i < 2; ++i) { const int q = 2 * w + i; \
        const int rho = 4 * q + ((ln_) >> 4), ch = ((ln_) & 15) ^ (rho & 15); \
        const int rg = q >> 1, c4 = 2 * (q & 1) + ((ln_) >> 5), r7 = ((ln_) & 31) >> 2, row = 8 * rg + r7, chv = 4 * c4 + (((ln_) & 3) ^ ((row >> 2) & 3)); \
        offK[i] = (unsigned)(rho * DHALF + DA + 8 * ch); offV[i] = (unsigned)(row * DHALF + 2 * DA + 8 * chv); }
#define AT_BASE(U) (PA + ((size_t)(U).b * SEQL + (U).rs0 * 64) * DHALF + (U).h * DH)
#define AT_ISSUE(base, off, rs0_, j) do { const int jj_ = min((j), 63 - (rs0_)); _Pragma("unroll") for (int i = 0; i < 2; ++i) \
            __builtin_amdgcn_global_load_lds((const GAS unsigned*)((base) + (size_t)jj_ * 64 * DHALF + off[i]), (LAS unsigned*)(F.lds + AT_RING + (j) * 16384 + 1024 * (2 * w + i)), 16, 0, 0); } while (0)
    if (AT_WU(0) >= NUN) return;
    { gcb PA = PA_; const AtUnit u0 = at_unit(AT_WU(0)); gcb b0 = AT_BASE(u0); const int l0_ = pg8::lane_id_asm(); AT_OFFS(l0_); (void)offV;
      __syncthreads();
      if (F.tid < DH) ((LAS float*)(F.lds + AT_GN))[F.tid] = qg_[F.tid] * kg_[F.tid];
      __syncthreads();
#pragma unroll
      for (int j = 0; j < 9; ++j) AT_ISSUE(b0, offK, u0.rs0, j); }
    for (int k = 0; k < per; ++k) {
        const int wu = AT_WU(k);
        if (wu >= NUN) break;
        const bool has_next = (k + 1 < per) && (AT_WU(k + 1) < NUN);
        const int lane = pg8::lane_id_asm();
        gcb PA = PA_; gb O_ = O0_; gcf qg = qg_, kg = kg_, rpb = rpb_, RKP = RKP_;
        asm volatile("" : "+s"(PA), "+s"(O_), "+s"(qg), "+s"(kg), "+s"(rpb), "+s"(RKP));
        const int m = lane & 15, g = lane >> 4, lq = m >> 2, lp = lane & 3;
        AT_OFFS(lane);
        const AtUnit U = at_unit(wu);
        const int b = U.b, h = U.h, r0 = U.r0, rs0 = U.rs0, r = r0 + (w >> 2), c0 = 16 * (w & 3);
        const int rs = min(max(r - 4, 0), 56), kc0 = min(max(c0 - 8, 0), 32), ro = rs - rs0;
        const size_t tokb = (size_t)b * SEQL;
        gcb baseU = AT_BASE(U);
        LAS float* rkt = (LAS float*)(F.lds + AT_RKT) + (k & 1) * 576;
        for (int e = 64 * w + lane; e < 576; e += NTHR) { const int krow = min(rs0 + (e >> 6), 63);
            const f32x4 p4 = *(const GAS f32x4*)(RKP + (tokb + krow * 64 + (e & 63)) * 32 + h * 4);
            rkt[e] = rsqrtf(((p4.x + p4.y) + (p4.z + p4.w)) * (1.f / DH) + EPS); }
        const LAS float* rkw = rkt + ro * 64 + kc0 + 4 * g;
        LAS float* rpt = (LAS float*)(F.lds + AT_RPB) + (k & 1) * 480;
        { const int e = 64 * w + lane; if (e < 465) rpt[e] = rpb[h * 465 + e]; }
        bf16x8_t Qf[4];
        {
            gcb qp = PA + (tokb + r * 64 + c0 + m) * DHALF + h * DH + 8 * g;
            v4u qr[4]; float ss = 0.f;
#pragma unroll
            for (int ks = 0; ks < 4; ++ks) { qr[ks] = *(const GAS v4u*)(qp + 32 * ks); ss += sumsq8(qr[ks]); }
            ss = pg8::sum_rows4(ss);
            const float rq = rsqrtf(ss * (1.f / DH) + EPS) * 0.08838834764831845f;
#pragma unroll
            for (int ks = 0; ks < 4; ++ks) {
                const f32x4 ga = *(const LAS f32x4*)(F.lds + AT_GN + 4 * (32 * ks + 8 * g)), gb_ = *(const LAS f32x4*)(F.lds + AT_GN + 4 * (32 * ks + 8 * g + 4));
                const v4u v = qr[ks]; v4u o;
                o.x = pk2(bflo(v.x) * rq * ga.x, bfhi(v.x) * rq * ga.y); o.y = pk2(bflo(v.y) * rq * ga.z, bfhi(v.y) * rq * ga.w);
                o.z = pk2(bflo(v.z) * rq * gb_.x, bfhi(v.z) * rq * gb_.y); o.w = pk2(bflo(v.w) * rq * gb_.z, bfhi(v.w) * rq * gb_.w);
                Qf[ks] = __builtin_bit_cast(bf16x8_t, o);
            }
        }
        f32x4 S[16];
#define AT_KSTEP(j, i) do { const LAS unsigned char* kb_ = F.lds + AT_RING + (j) * 16384; bf16x8_t kf_[2][4]; \
            _Pragma("unroll") for (int hf = 0; hf < 2; ++hf) { const int rho = kc0 + 16 * hf + m; \
                _Pragma("unroll") for (int ks = 0; ks < 4; ++ks) kf_[hf][ks] = *(const LAS bf16x8_t*)(kb_ + 256 * rho + 16 * ((4 * ks + g) ^ (rho & 15))); } \
            __builtin_amdgcn_sched_barrier(0);                                \
            _Pragma("unroll") for (int hf = 0; hf < 2; ++hf) { f32x4 a = pg8::zero4(); \
                _Pragma("unroll") for (int ks = 0; ks < 4; ++ks) a = __builtin_amdgcn_mfma_f32_16x16x32_bf16(kf_[hf][ks], Qf[ks], a, 0, 0, 0); \
                S[2 * (i) + hf] = a; } } while (0)
#define AT_KITER(j) do { AT_WAIT(14); AT_BAR(); if ((j) >= 1) AT_ISSUE(baseU, offV, rs0, (j) - 1); \
            if (ro == 0) { if ((j) < 8) AT_KSTEP(j, ((j) < 8 ? (j) : 0)); } else { if ((j) >= 1) AT_KSTEP(j, ((j) >= 1 ? (j) - 1 : 0)); } } while (0)
        AT_KITER(0); AT_KITER(1); AT_KITER(2); AT_KITER(3); AT_KITER(4); AT_KITER(5); AT_KITER(6); AT_KITER(7); AT_KITER(8);
#undef AT_KSTEP
#undef AT_KITER
        const int qc = c0 + m, cs = min(max(qc - 8, 0), 48);
        float mx = -3.0e38f;
#pragma unroll
        for (int half = 0; half < 8; ++half) {
            float bv[2][4];
#pragma unroll
            for (int t8 = 0; t8 < 2; ++t8) { const int T = 2 * half + t8; const int dr = rs + (T >> 1) - r + 7; const LAS float* bp = rpt + dr * 31 + 15 - qc;
#pragma unroll
                for (int rr = 0; rr < 4; ++rr) { const int kcol = kc0 + 16 * (T & 1) + 4 * g + rr; const bool ok = (kcol >= cs) && (kcol < cs + 16); bv[t8][rr] = bp[ok ? kcol : qc]; } }
#pragma unroll
            for (int t8 = 0; t8 < 2; ++t8) asm volatile("" : "+v"(bv[t8][0]), "+v"(bv[t8][1]), "+v"(bv[t8][2]), "+v"(bv[t8][3]));
#pragma unroll
            for (int t8 = 0; t8 < 2; ++t8) { const int T = 2 * half + t8;
                const f32x4 rk4 = *(const LAS f32x4*)(rkw + 64 * (T >> 1) + 16 * (T & 1));
#pragma unroll
                for (int rr = 0; rr < 4; ++rr) {
                    const int kcol = kc0 + 16 * (T & 1) + 4 * g + rr;
                    const bool ok = (kcol >= cs) && (kcol < cs + 16);
                    const float sv = ok ? S[T][rr] * rk4[rr] + bv[t8][rr] : -3.0e38f;
                    S[T][rr] = sv; mx = fmaxf(mx, sv);
                } }
        }
        mx = pg8::max_rows4(mx);
        float sum = 0.f;
#pragma unroll
        for (int T = 0; T < 16; ++T)
#pragma unroll
            for (int rr = 0; rr < 4; ++rr) { const float p = (S[T][rr] > -1.0e38f) ? __expf(S[T][rr] - mx) : 0.f; S[T][rr] = p; sum += p; }
        sum = pg8::sum_rows4(sum);
        const float inv = 1.f / sum;
        bf16x8_t Pf[8];
#pragma unroll
        for (int i = 0; i < 8; ++i) { v4u o; o.x = pk2(S[2 * i][0], S[2 * i][1]); o.y = pk2(S[2 * i][2], S[2 * i][3]); o.z = pk2(S[2 * i + 1][0], S[2 * i + 1][1]); o.w = pk2(S[2 * i + 1][2], S[2 * i + 1][3]);
            Pf[i] = __builtin_bit_cast(bf16x8_t, o); }
        const unsigned ldsb = (unsigned)(uintptr_t)F.lds, vE = img_off<16>(kc0 + 4 * g + lq, (lp >> 1)) + 8 * (lp & 1), vO = vE ^ 32u;
        AtUnit Un = U; if (has_next) Un = at_unit(AT_WU(k + 1));
        gcb baseN = AT_BASE(Un);
        f32x4 O[8];
#pragma unroll
        for (int dt = 0; dt < 8; ++dt) O[dt] = pg8::zero4();
#define AT_TR(dst, addr, off) asm volatile("ds_read_b64_tr_b16 %0, %1 offset:%2" : "=v"(dst) : "v"(addr), "n"(off))
#define AT_VSTEP(j, i) do { const unsigned aE_ = ldsb + vE + (unsigned)(AT_RING + (j) * 16384), aO_ = ldsb + vO + (unsigned)(AT_RING + (j) * 16384); s16x4_t tq_[16]; \
            AT_TR(tq_[0], aE_, 0); AT_TR(tq_[1], aE_, 4096); AT_TR(tq_[2], aO_, 0); AT_TR(tq_[3], aO_, 4096); \
            AT_TR(tq_[4], aE_, 512); AT_TR(tq_[5], aE_, 4608); AT_TR(tq_[6], aO_, 512); AT_TR(tq_[7], aO_, 4608); \
            AT_TR(tq_[8], aE_, 1024); AT_TR(tq_[9], aE_, 5120); AT_TR(tq_[10], aO_, 1024); AT_TR(tq_[11], aO_, 5120); \
            AT_TR(tq_[12], aE_, 1536); AT_TR(tq_[13], aE_, 5632); AT_TR(tq_[14], aO_, 1536); AT_TR(tq_[15], aO_, 5632); \
            asm volatile("s_waitcnt lgkmcnt(0)" : "+v"(tq_[0]), "+v"(tq_[1]), "+v"(tq_[2]), "+v"(tq_[3]), "+v"(tq_[4]), "+v"(tq_[5]), "+v"(tq_[6]), "+v"(tq_[7]), \
                         "+v"(tq_[8]), "+v"(tq_[9]), "+v"(tq_[10]), "+v"(tq_[11]), "+v"(tq_[12]), "+v"(tq_[13]), "+v"(tq_[14]), "+v"(tq_[15])); \
            _Pragma("unroll") for (int dt = 0; dt < 8; ++dt) { \
                const bf16x8_t Vf = __builtin_shufflevector(tq_[2 * dt], tq_[2 * dt + 1], 0, 1, 2, 3, 4, 5, 6, 7); \
                O[dt] = __builtin_amdgcn_mfma_f32_16x16x32_bf16(Vf, Pf[i], O[dt], 0, 0, 0); } } while (0)
#define AT_VCOMP(j) do { if (ro == 0) { if ((j) < 8) AT_VSTEP(j, ((j) < 8 ? (j) : 0)); } else { if ((j) >= 1) AT_VSTEP(j, ((j) >= 1 ? (j) - 1 : 0)); } } while (0)
        if (has_next) {
#define AT_VITER(j) do { AT_WAIT(14); AT_BAR(); if ((j) == 0) AT_ISSUE(baseU, offV, rs0, 8); else AT_ISSUE(baseN, offK, Un.rs0, (j) - 1); AT_VCOMP(j); } while (0)
            AT_VITER(0); AT_VITER(1); AT_VITER(2); AT_VITER(3); AT_VITER(4); AT_VITER(5); AT_VITER(6); AT_VITER(7); AT_VITER(8);
#undef AT_VITER
        } else {
#define AT_VITER(j, n) do { AT_WAIT(n); AT_BAR(); if ((j) == 0) AT_ISSUE(baseU, offV, rs0, 8); AT_VCOMP(j); } while (0)
            AT_VITER(0, 14); AT_VITER(1, 14); AT_VITER(2, 12); AT_VITER(3, 10); AT_VITER(4, 8); AT_VITER(5, 6); AT_VITER(6, 4); AT_VITER(7, 2); AT_VITER(8, 0);
#undef AT_VITER
        }
#undef AT_VSTEP
#undef AT_TR
#undef AT_VCOMP
        gb op = O_ + (tokb + r * 64 + c0 + m) * ldo + h * DH + 4 * g;
#pragma unroll
        for (int dt = 0; dt < 8; ++dt) { const f32x4 o = O[dt] * inv; *(GAS v2u*)(op + 16 * dt) = (v2u){pk2(o.x, o.y), pk2(o.z, o.w)}; }
        if (has_next) {
            AT_BAR();
            AT_ISSUE(baseN, offK, Un.rs0, 8);
        }
    }
#undef AT_ISSUE
#undef AT_OFFS
#undef AT_BASE
#undef AT_WU
}
#undef AT_WAIT
#undef AT_BAR
constexpr int GM_W_OFF = 65536, GM_WRS = 288;
struct GateRegs { v4u v[8]; f32x4 p0, p1; };
__device__ __forceinline__ void gate_load(GateRegs& R, gcb ZZ, gcf RVS, int unit, int tid) {
    const int n = unit >> 3, gch = unit & 7, tok0 = n * 128;
#pragma unroll
    for (int x = 0; x < 8; ++x) { const int e = tid + NTHR * x, row = e >> 5, ch = e & 31; R.v[x] = *(const GAS v4u*)(ZZ + (size_t)(tok0 + row) * DC2 + DM + gch * 256 + 8 * ch); }
    gcf pp = RVS + (size_t)(tok0 + (tid >> 2)) * 32 + 8 * (tid & 3);
    R.p0 = *(const GAS f32x4*)pp; R.p1 = *(const GAS f32x4*)(pp + 4);
}
__device__ __forceinline__ void gate_rv(const GateRegs& R, LAS float* rvl, int tid) {
    float sacc = ((R.p0[0] + R.p0[1]) + (R.p0[2] + R.p0[3])) + ((R.p1[0] + R.p1[1]) + (R.p1[2] + R.p1[3]));
    sacc += swz_xor<1>(sacc); sacc += swz_xor<2>(sacc);
    if ((tid & 3) == 0) rvl[tid >> 2] = rsqrtf(sacc * (1.f / DM) + EPS);
}
__device__ __forceinline__ unsigned scale2(unsigned w, float r) { return pk2(bflo(w) * r, bfhi(w) * r); }
__device__ __forceinline__ void gmlp_gate_mfma(Frame& F, gb ZZ, gcf vgain, gcf ws_, gcf bs_) {
    const int w = F.wave;
    LAS float* rvl = (LAS float*)(F.lds + GM_W_OFF + 128 * GM_WRS);
    const int NU = (M / 128) * 8;
    if ((F.G & 7) != 0) return;
    const int gch = F.bx & 7;
    int unit = F.bx;
    GateRegs R;
    if (unit < NU) gate_load(R, ZZ, F.RVS, unit, F.tid);
    __syncthreads();
    for (int e = F.tid; e < 128 * 16; e += NTHR) { const int p = e >> 4, q8 = e & 15; gcf wp = ws_ + (size_t)gch * 16384 + p * 128 + 8 * q8;
        const f32x4 a = *(const GAS f32x4*)wp, bq = *(const GAS f32x4*)(wp + 4);
        *(LAS v4u*)(F.lds + GM_W_OFF + p * GM_WRS + 16 * q8) = (v4u){pk2(a.x, a.y), pk2(a.z, a.w), pk2(bq.x, bq.y), pk2(bq.z, bq.w)}; }
    if (unit < NU) gate_rv(R, rvl, F.tid);
    int par = 0;
    for (; unit < NU; unit += F.G, par ^= 1) {
        const int tok0 = (unit >> 3) * 128;
        int lane_ = F.lane; asm volatile("" : "+v"(lane_));
        const int m = lane_ & 15, g4 = lane_ >> 4, lq = m >> 2, lp = lane_ & 3;
        __syncthreads();
#pragma unroll
        for (int x = 0; x < 8; ++x) { const int e = F.tid + NTHR * x; const float r = rvl[par * 128 + (e >> 5)]; const v4u v = R.v[x];
            *(LAS v4u*)(F.lds + img_off<32>(e >> 5, e & 31)) = (v4u){scale2(v.x, r), scale2(v.y, r), scale2(v.z, r), scale2(v.w, r)}; }
        if (unit + F.G < NU) gate_load(R, ZZ, F.RVS, unit + F.G, F.tid);
        __syncthreads();
        f32x4 acc[8][2];
#pragma unroll
        for (int mt = 0; mt < 8; ++mt) { acc[mt][0] = pg8::zero4(); acc[mt][1] = pg8::zero4(); }
#pragma unroll
        for (int ks = 0; ks < 4; ++ks) {
            bf16x8_t Vf[2];
#pragma unroll
            for (int jj = 0; jj < 2; ++jj) { const int ct = 2 * w + jj;
                const s16x4_t t0 = ds_tr(F.lds + img_off<32>(32 * ks + 8 * g4 + lq, 2 * ct + (lp >> 1)) + 8 * (lp & 1));
                const s16x4_t t1 = ds_tr(F.lds + img_off<32>(32 * ks + 8 * g4 + 4 + lq, 2 * ct + (lp >> 1)) + 8 * (lp & 1));
                Vf[jj] = __builtin_shufflevector(t0, t1, 0, 1, 2, 3, 4, 5, 6, 7); }
#pragma unroll
            for (int mt = 0; mt < 8; ++mt) { const bf16x8_t Wf = *(const LAS bf16x8_t*)(F.lds + GM_W_OFF + (16 * mt + m) * GM_WRS + 64 * ks + 16 * g4);
                acc[mt][0] = __builtin_amdgcn_mfma_f32_16x16x32_bf16(Vf[0], Wf, acc[mt][0], 0, 0, 0);
                acc[mt][1] = __builtin_amdgcn_mfma_f32_16x16x32_bf16(Vf[1], Wf, acc[mt][1], 0, 0, 0); }
        }
        if (unit + F.G < NU) gate_rv(R, rvl + (par ^ 1) * 128, F.tid);
        const int colb = gch * 256 + 32 * w + 4 * g4;
        const f32x4 gn0 = *(const GAS f32x4*)(vgain + colb), gn1 = *(const GAS f32x4*)(vgain + colb + 16);
        gb ub = ZZ + (size_t)(tok0 + m) * DC2 + colb;
        float bsq[8]; v2u uq[8][2];
#pragma unroll
        for (int mt = 0; mt < 8; ++mt) { bsq[mt] = bs_[gch * 128 + 16 * mt + m];
#pragma unroll
            for (int jj = 0; jj < 2; ++jj) uq[mt][jj] = *(const GAS v2u*)(ub + (size_t)(16 * mt) * DC2 + 16 * jj); }
#pragma unroll
        for (int mt = 0; mt < 8; ++mt) { asm volatile("" : "+v"(bsq[mt]));
#pragma unroll
            for (int jj = 0; jj < 2; ++jj) asm volatile("" : "+v"(uq[mt][jj])); }
#pragma unroll
        for (int mt = 0; mt < 8; ++mt) { const float bsp = bsq[mt];
#pragma unroll
            for (int jj = 0; jj < 2; ++jj) { const f32x4 gn = jj ? gn1 : gn0; const f32x4 sv = acc[mt][jj] * gn + bsp;
                const v2u uu = uq[mt][jj];
                *(GAS v2u*)(ub + (size_t)(16 * mt) * DC2 + 16 * jj) = (v2u){pk2(bflo(uu.x) * sv.x, bfhi(uu.x) * sv.y), pk2(bflo(uu.y) * sv.z, bfhi(uu.y) * sv.w)}; } }
    }
}

__device__ __forceinline__ void make_frame(Frame& F, const Params*& kp, int wbase) {
    const Params* k = (const Params*)__builtin_amdgcn_kernarg_segment_ptr();
    asm volatile("" : "+s"(k));
    kp = k;
    const int t_ = wbase + pg8::lane_id_asm();
    extern __shared__ __attribute__((aligned(16))) unsigned char lds_raw[];
    F.lds = (LAS unsigned char*)lds_raw;
    F.MISC = (volatile LAS unsigned*)(F.lds + MISC_OFF);
    F.tid = t_; F.lane = t_ & 63; { int wv = wbase >> 6; asm volatile("" : "+s"(wv)); F.wave = wv; } F.wbase = wbase;
    F.G = gridDim.x; { int bx = blockIdx.x; asm volatile("" : "+s"(bx)); F.bx = bx; F.vcu = (F.G % 8 == 0) ? (bx % 8) * (F.G / 8) + bx / 8 : bx; }
    GAS unsigned char* ws = (GAS unsigned char*)k->ws; F.ws = ws;
    F.ctl = (gu32*)(ws + WS_CTL);
    F.xp = (gcf)k->in[0]; F.xs = (gcf)k->in[1]; F.out = (gf)k->out;
    F.W1 = (gb)(ws + WS_W1); F.W2 = (gb)(ws + WS_W2); F.XB = (gb)(ws + WS_XB);
    F.FILT = (gf)(ws + WS_FILT); F.SSA = (gb)(ws + WS_SSA); F.SSB = (gb)(ws + WS_SSB); F.RVS = (gf)(ws + WS_RVS); F.INVS = (gf)(ws + WS_INVS); F.RVF = (gb)(ws + WS_RVF);
}
__device__ __forceinline__ void grid_bar() {
    const Params* k = (const Params*)__builtin_amdgcn_kernarg_segment_ptr();
    asm volatile("" : "+s"(k));
    extern __shared__ __attribute__((aligned(16))) unsigned char lds_raw[];
    XcdBarrier b; b.bar = (unsigned*)(k->ws + WS_CTL) + CW_BAR; b.x = xb_xcc_id(); b.st = (volatile LAS unsigned*)((LAS unsigned char*)lds_raw + MISC_OFF) + 8;
    xcd_barrier(b);
}
constexpr int NPHASES = 25;
__global__ void __launch_bounds__(NTHR, 2) fwd_kernel(Params P) {
    extern __shared__ __attribute__((aligned(16))) unsigned char lds_raw[];
    {
        volatile LAS unsigned* MISC = (volatile LAS unsigned*)((LAS unsigned char*)lds_raw + MISC_OFF);
        if (threadIdx.x < 32) MISC[threadIdx.x] = 0u;
        __syncthreads();
    }
    const int lo = P.ph_lo, hi = P.ph_hi;
    const int wbase = __builtin_amdgcn_readfirstlane(threadIdx.x);
    if (hi - lo > 1) (void)xcd_barrier_post((unsigned*)(P.ws + WS_CTL) + CW_BAR, (volatile LAS unsigned*)((LAS unsigned char*)lds_raw + MISC_OFF) + 8);
    int ph = 0;
#define PH_BEGIN if (ph >= lo && ph < hi) { Frame F; const Params* kp; make_frame(F, kp, wbase); \
    const gb BIG = (gb)(F.ws + WS_BIG); const gb PA = (gb)(F.ws + WS_BIG + BIG_PA); const gb PB = (gb)(F.ws + WS_BIG + BIG_PB); \
    const gb UT = (gb)(F.ws + WS_BIG + BIG_UT); const gb X0T = (gb)(F.ws + WS_BIG + BIG_X0T); const gb GT = PB; \
    const gb WINc = (gb)(F.ws + ((layer & 1) ? WS_WIN2 : WS_WIN)); const gb WOUTc = (gb)(F.ws + ((layer & 1) ? WS_WOUT2 : WS_WOUT)); \
    (void)BIG; (void)PA; (void)PB; (void)UT; (void)X0T; (void)GT; (void)WINc; (void)WOUTc;
#define PH_END if (ph + 1 < hi) grid_bar(); } ++ph;
#define LAYER_CHORES() do { \
        gcf nmix = ((gcf)kp->in[2]) + (layer + 1) * DM; gcf nmlp = ((gcf)kp->in[3]) + layer * DM; \
        gcf w1f = ((gcf)kp->in[25]) + (size_t)layer * DM * DFF; gcf w2f = ((gcf)kp->in[26]) + (size_t)layer * DFF * DM; \
        if (layer == 0) { const CvtJob jobs[2] = { {((gcf)kp->in[20]), nmix, (gb)(F.ws + WS_WIN2), DM, DC2}, {((gcf)kp->in[24]), nullptr, (gb)(F.ws + WS_WOUT2), DM, DM} }; convert_jobs<2>(F, jobs, 0); } \
        else if (layer == 1) { const CvtJob jobs[4] = { {((gcf)kp->in[4]) + (size_t)DM * DINAB, nmix, (gb)(F.ws + WS_WIN), DM, DINAB}, {((gcf)kp->in[19]) + (size_t)DM * DM, nullptr, (gb)(F.ws + WS_WOUT), DM, DM}, \
                                                         {w1f, nmlp, F.W1, DM, DFF}, {w2f, nullptr, F.W2, DFF, DM} }; convert_jobs<4>(F, jobs, 0); } \
        else if (layer == 2) { const CvtJob jobs[4] = { {((gcf)kp->in[20]) + (size_t)DM * DC2, nmix, (gb)(F.ws + WS_WIN2), DM, DC2}, {((gcf)kp->in[24]) + (size_t)DM * DM, nullptr, (gb)(F.ws + WS_WOUT2), DM, DM}, \
                                                         {w1f, nmlp, F.W1, DM, DFF}, {w2f, nullptr, F.W2, DFF, DM} }; convert_jobs<4>(F, jobs, 0); } \
        else { const CvtJob jobs[2] = { {w1f, nmlp, F.W1, DM, DFF}, {w2f, nullptr, F.W2, DFF, DM} }; convert_jobs<2>(F, jobs, 0); } \
    } while (0)

    {
        const int layer = 0;
        PH_BEGIN
              xb_rows(F);
            const CvtJob jobs[4] = { {((gcf)kp->in[4]), ((gcf)kp->in[2]), WINc, DM, DINAB}, {((gcf)kp->in[19]), nullptr, WOUTc, DM, DM}, {((gcf)kp->in[25]), ((gcf)kp->in[3]), F.W1, DM, DFF}, {((gcf)kp->in[26]), nullptr, F.W2, DFF, DM} };
              convert_jobs<4>(F, jobs, 0);
            filter_gen(F, ((gcf)kp->in[10]), ((gcf)kp->in[11]), ((gcf)kp->in[12]), ((gcf)kp->in[13]), ((gcf)kp->in[14]), ((gcf)kp->in[15]), ((gcf)kp->in[16]), ((gcf)kp->in[17]));
        PH_END
    }
    for (int layer = 0; layer < 4; ++layer) {
        const int j = layer >> 1;
        if ((layer & 1) == 0) {
            PH_BEGIN
                pg8::Gemm g{(const bf16*)F.XB, (const bf16*)WINc, M, DINAB, DM, DM, F.wbase}; pg8::StaticOrder S; S.init(M, DINAB, F.G, F.bx);
                pg8::EpiBf16<0, false, true> E{PA, DHALF, DHALF, (size_t)(PB - PA), F.SSA, F.RVS, 0, F.lds + RING_BYTES};
                pg8::gemm_phase<pg8::EpiBf16<0, false, true>, pg8::StaticOrder, true, true>(F.lds, g, S, E);
            PH_END
            PH_BEGIN
                  hyena_prep(F, PB, UT, X0T, ((gcf)kp->in[5]) + j * 3 * DHALF, ((gcf)kp->in[6]) + j * DHALF);
                filter_norm(F);
                __syncthreads();
                  LAYER_CHORES();
                __syncthreads();
                make_frame(F, kp, wbase);
                  attn_coop(F, (gcb)(F.ws + WS_BIG + BIG_PA), (gb)(F.ws + WS_BIG + BIG_PA), DHALF, ((gcf)kp->in[7]) + j * DH, ((gcf)kp->in[8]) + j * DH, ((gcf)kp->in[9]) + j * HA * 15 * 31, F.RVS);
            PH_END
            PH_BEGIN
                hyena_conv_mfma(F, UT, X0T, GT, ((gcf)kp->in[18]) + j * DB);
            PH_END
            PH_BEGIN
                hyena_post(F, GT, PA + DA, DHALF);
            PH_END
            PH_BEGIN
                pg8::Gemm g{(const bf16*)PA, (const bf16*)WOUTc, M, DM, DM, DHALF, F.wbase}; pg8::StaticOrder S; S.init(M, DM, F.G, F.bx);
                { pg8::EpiRes<1> E{nullptr, nullptr, 0, F.out, DM, F.XB, F.SSB};
                    pg8::gemm_phase<pg8::EpiRes<1>, pg8::StaticOrder, true, true>(F.lds, g, S, E); }
            PH_END
        } else {
            PH_BEGIN
                pg8::Gemm g{(const bf16*)F.XB, (const bf16*)WINc, M, DC2, DM, DM, F.wbase}; pg8::StaticOrder S; S.init(M, DC2, F.G, F.bx);
                pg8::EpiBf16<1, true> E{BIG, DC2, 0, 0, F.SSA, F.RVS, 8, F.lds + RING_BYTES};
                pg8::gemm_phase<pg8::EpiBf16<1, true>, pg8::StaticOrder, true, true>(F.lds, g, S, E);
            PH_END
            PH_BEGIN
                  gmlp_gate_mfma(F, BIG, ((gcf)kp->in[21]) + j * DM, ((gcf)kp->in[22]) + (size_t)j * 8 * 128 * 128, ((gcf)kp->in[23]) + j * 8 * 128);
                __syncthreads();
                  LAYER_CHORES();
                  if (layer == 1) filter_gen(F, ((gcf)kp->in[10]) + EMB * FO, ((gcf)kp->in[11]) + FO, ((gcf)kp->in[12]) + FO * FO, ((gcf)kp->in[13]) + FO, ((gcf)kp->in[14]) + FO * FO, ((gcf)kp->in[15]) + FO, ((gcf)kp->in[16]) + (size_t)FO * 2 * DB, ((gcf)kp->in[17]) + FO);
            PH_END
            PH_BEGIN
                pg8::Gemm g{(const bf16*)BIG, (const bf16*)WOUTc, M, DM, DM, DC2, F.wbase}; pg8::StaticOrder S; S.init(M, DM, F.G, F.bx);
                pg8::EpiRes<1> E{nullptr, nullptr, 0, F.out, DM, F.XB, F.SSB};
                pg8::gemm_phase<pg8::EpiRes<1>, pg8::StaticOrder, true, true>(F.lds, g, S, E);
            PH_END
        }
        PH_BEGIN
            pg8::Gemm g{(const bf16*)F.XB, (const bf16*)F.W1, M, DFF, DM, DM, F.wbase}; pg8::StaticOrder S; S.init(M, DFF, F.G, F.bx);
            pg8::EpiBf16<2, false> E{BIG, DFF, 0, 0, F.SSB, nullptr, 0, F.lds + RING_BYTES};
            pg8::gemm_phase<pg8::EpiBf16<2, false>, pg8::StaticOrder, true, true>(F.lds, g, S, E);
        PH_END
        PH_BEGIN
            pg8::Gemm g{(const bf16*)BIG, (const bf16*)F.W2, M, DM, DFF, DFF, F.wbase}; pg8::StaticOrder S; S.init(M, DM, F.G, F.bx);
            if (layer < 3) { pg8::EpiRes<1> E{nullptr, nullptr, 0, F.out, DM, F.XB, F.SSA};
                pg8::gemm_phase<pg8::EpiRes<1>, pg8::StaticOrder, true, true>(F.lds, g, S, E); }
            else { pg8::EpiRes<2> E{nullptr, nullptr, 0, F.out, DM, F.XB, F.SSA};
                pg8::gemm_phase<pg8::EpiRes<2>, pg8::StaticOrder, true, true>(F.lds, g, S, E); }
        PH_END
    }
#undef PH_BEGIN
#undef PH_END
#undef LAYER_CHORES
}

#ifndef MK_ONE_LAUNCH
#define MK_ONE_LAUNCH 1
#endif
extern "C" void kernel_launch(void* const* d_in, const int* in_sizes, int n_in, void* d_out, int out_size, void* d_ws, size_t ws_size, hipStream_t stream) {
    static int grid = 0;
    if (grid == 0) {
        if (n_in != 27 || out_size != M * DM || ws_size < WS_END) { fprintf(stderr, "kernel_launch: unexpected shapes (n_in %d out %d ws %zu)\n", n_in, out_size, ws_size); grid = -1; return; }
        int dev = 0, cus = 0;
        if (hipGetDevice(&dev) != hipSuccess || hipDeviceGetAttribute(&cus, hipDeviceAttributeMultiprocessorCount, dev) != hipSuccess) { grid = -1; return; }
        if (hipFuncSetAttribute((const void*)fwd_kernel, hipFuncAttributeMaxDynamicSharedMemorySize, LDS_BYTES) != hipSuccess) { fprintf(stderr, "kernel_launch: hipFuncSetAttribute failed\n"); grid = -1; return; }
        (void)hipGetLastError();
        grid = cus;
    }
    if (grid < 0) return;
    (void)hipMemsetAsync((char*)d_ws + WS_CTL, 0, CTL_ZERO_BYTES, stream);
    Params p{};
    for (int i = 0; i < 27; ++i) p.in[i] = (const float*)d_in[i];
    p.out = (float*)d_out; p.ws = (unsigned char*)d_ws;
#if MK_ONE_LAUNCH
    p.ph_lo = 0; p.ph_hi = NPHASES;
    hipLaunchKernelGGL(fwd_kernel, dim3(grid), dim3(NTHR), LDS_BYTES, stream, p);
#else
    for (int ph = 0; ph < NPHASES; ++ph) { p.ph_lo = ph; p.ph_hi = ph + 1; hipLaunchKernelGGL(fwd_kernel, dim3(grid), dim3(NTHR), LDS_BYTES, stream, p); }
#endif
}
```
